# Optimizing an MI355X kernel written in HIP

```python
import jax, jax.numpy as jnp
from jax import lax
import numpy as np

D_MODEL = 1024
BATCH = 2
SEQ = 8192
DEPTH = 4

N_MIXERS = 3
CHUNK = 128
GM_WIDTH = 2 * D_MODEL
GM_GROUPS = 8
GM_GROUP_DIM = GM_WIDTH // GM_GROUPS
FOX_HEADS = 16
FOX_HEAD_DIM = D_MODEL // FOX_HEADS
Q_BLOCK = 128
POOL_WINDOWS = (2, 4, 8, 16)
POOL_GROUPS = len(POOL_WINDOWS)
POOL_WIDTH = D_MODEL
POOL_GROUP_DIM = POOL_WIDTH // POOL_GROUPS
D_FF = 7 * D_MODEL // 2
N_EXPERTS = 8
TOP_K = 2
EXPERT_BLOCK = 512
DN_ALPHA = (2 * DEPTH) ** 0.25
DN_BETA = (8 * DEPTH) ** -0.25
LN_EPS = 1e-5
MOD_SCALE = 0.25

N_GM = (DEPTH + 2) // 3
N_FOX = (DEPTH + 1) // 3
N_POOL = DEPTH // 3
N_DENSE = (DEPTH + 1) // 2
N_MOE = DEPTH // 2

kernel_name = 'hybrid_gmlp_fox_pool_moe_deepnorm_adaln'


def layer_norm(x, g, b):
    xf = x.astype(jnp.float32)
    mu = jnp.mean(xf, axis=-1, keepdims=True)
    var = jnp.mean(jnp.square(xf - mu), axis=-1, keepdims=True)
    y = (xf - mu) * lax.rsqrt(var + LN_EPS)
    return (y * g.astype(jnp.float32) + b.astype(jnp.float32)).astype(x.dtype)


def gmlp_chunk_mixer(h, w_in, ln_g, ln_b, w_s, b_s, w_out):
    B_, S_, _ = h.shape
    z = jax.nn.gelu(h @ w_in, approximate=False)
    u, v = jnp.split(z, 2, axis=-1)
    v = layer_norm(v, ln_g, ln_b)
    v = v.reshape(B_, S_ // CHUNK, CHUNK, GM_GROUPS, GM_GROUP_DIM)
    causal = jnp.tril(jnp.ones((CHUNK, CHUNK), dtype=bool))
    w = jnp.where(causal[None], w_s, 0).astype(v.dtype)
    mixed = jnp.einsum('gts,bnsgc->bntgc', w, v) + b_s.T[:, :, None].astype(v.dtype)
    mixed = mixed.reshape(B_, S_, GM_WIDTH)
    return (u * mixed) @ w_out


def forgetting_attention(h, w_in, b_f, w_out):
    B_, S_, _ = h.shape
    proj = h @ w_in
    q, k, v, f = jnp.split(proj, [D_MODEL, 2 * D_MODEL, 3 * D_MODEL], axis=-1)

    def to_heads(t):
        return t.reshape(B_, S_, FOX_HEADS, FOX_HEAD_DIM).transpose(0, 2, 1, 3)

    q, k, v = to_heads(q), to_heads(k), to_heads(v)
    log_f = jax.nn.log_sigmoid((f + b_f).astype(jnp.float32))
    cum = jnp.cumsum(log_f, axis=1).transpose(0, 2, 1)
    scale = FOX_HEAD_DIM ** -0.5
    key_pos = jnp.arange(S_)

    def query_block(i):
        start = i * Q_BLOCK
        qb = lax.dynamic_slice_in_dim(q, start, Q_BLOCK, axis=2)
        cq = lax.dynamic_slice_in_dim(cum, start, Q_BLOCK, axis=2)
        s = jnp.einsum('bhqd,bhkd->bhqk', qb, k).astype(jnp.float32) * scale
        s = s + cq[..., :, None] - cum[..., None, :]
        q_pos = start + jnp.arange(Q_BLOCK)
        mask = key_pos[None, :] <= q_pos[:, None]
        p = jax.nn.softmax(jnp.where(mask, s, -jnp.inf), axis=-1)
        return jnp.einsum('bhqk,bhkd->bhqd', p.astype(v.dtype), v)

    out = lax.map(query_block, jnp.arange(S_ // Q_BLOCK))
    out = out.transpose(1, 0, 3, 2, 4).reshape(B_, S_, D_MODEL)
    return out @ w_out


def multiscale_pool_mixer(h, w_in, w_grp, layer_scale, w_out):
    B_, S_, _ = h.shape
    z = h @ w_in
    zf = z.astype(jnp.float32)
    cs = jnp.pad(jnp.cumsum(zf, axis=1), ((0, 0), (1, 0), (0, 0)))
    pos = jnp.arange(S_)
    outs = []
    for g, win in enumerate(POOL_WINDOWS):
        lo_c, hi_c = g * POOL_GROUP_DIM, (g + 1) * POOL_GROUP_DIM
        cs_g = cs[..., lo_c:hi_c]
        lo = jnp.maximum(pos + 1 - win, 0)
        window_sum = cs_g[:, 1:, :] - cs_g[:, lo, :]
        count = jnp.minimum(pos + 1, win).astype(jnp.float32)
        pooled = window_sum / count[None, :, None] - zf[..., lo_c:hi_c]
        outs.append(jnp.einsum('bsc,cd->bsd', pooled.astype(z.dtype), w_grp[g]))
    y = jnp.concatenate(outs, axis=-1) * layer_scale
    return y @ w_out


def swiglu(h, w13, w2):
    a, b = jnp.split(h @ w13, 2, axis=-1)
    return (jax.nn.silu(a) * b) @ w2


def moe_swiglu(h, w_router, b_router, w13, w2):
    B_, S_, D = h.shape
    xt = h.reshape(-1, D)
    T = xt.shape[0]
    logits = (xt @ w_router).astype(jnp.float32) + b_router.astype(jnp.float32)
    top_val, top_idx = lax.top_k(logits, TOP_K)
    gates = jax.nn.softmax(top_val, axis=-1)
    n_assign = T * TOP_K
    e_flat = top_idx.reshape(-1).astype(jnp.int32)
    tok_flat = jnp.repeat(jnp.arange(T, dtype=jnp.int32), TOP_K)
    g_flat = gates.reshape(-1)
    order = jnp.argsort(e_flat * n_assign + jnp.arange(n_assign, dtype=jnp.int32))
    e_sorted, tok_sorted, g_sorted = e_flat[order], tok_flat[order], g_flat[order]
    counts = jnp.bincount(e_flat, length=N_EXPERTS)
    padded = (counts + EXPERT_BLOCK - 1) // EXPERT_BLOCK * EXPERT_BLOCK
    pad_end = jnp.cumsum(padded)
    pad_start = pad_end - padded
    raw_start = jnp.cumsum(counts) - counts
    dest = pad_start[e_sorted] + (jnp.arange(n_assign) - raw_start[e_sorted])
    capacity = (n_assign + EXPERT_BLOCK - 1) // EXPERT_BLOCK * EXPERT_BLOCK + N_EXPERTS * EXPERT_BLOCK
    n_blocks = capacity // EXPERT_BLOCK
    slot_tok = jnp.full((capacity,), T, dtype=jnp.int32).at[dest].set(tok_sorted)
    x_pad = jnp.concatenate([xt, jnp.zeros((1, D), xt.dtype)], axis=0)
    x_slots = x_pad[slot_tok].reshape(n_blocks, EXPERT_BLOCK, D)
    block_expert = jnp.minimum(
        jnp.searchsorted(pad_end, jnp.arange(n_blocks) * EXPERT_BLOCK, side='right'),
        N_EXPERTS - 1)

    def expert_block(args):
        xb, e = args
        return swiglu(xb, w13[e], w2[e])

    y_slots = lax.map(expert_block, (x_slots, block_expert)).reshape(capacity, D)
    y = jnp.zeros_like(xt).at[tok_sorted].add(y_slots[dest] * g_sorted[:, None].astype(xt.dtype))
    return y.reshape(B_, S_, D)


def setup_inputs(seed: int = 0) -> dict:
    key = jax.random.key(seed)
    ks = jax.random.split(key, 24)
    nrm = jax.random.normal
    D, F, E = D_MODEL, D_FF, N_EXPERTS
    return {
        'x': nrm(ks[0], (BATCH, SEQ, D), jnp.float32),
        'c': nrm(ks[1], (BATCH, D), jnp.float32),
        'mod_w': nrm(ks[2], (DEPTH, D, 6 * D), jnp.float32) * (MOD_SCALE * D ** -0.5),
        'mod_b': nrm(ks[3], (DEPTH, 6 * D), jnp.float32) * 0.02,
        'ln_g': 1.0 + 0.02 * nrm(ks[4], (DEPTH, 2, D), jnp.float32),
        'ln_b': 0.02 * nrm(ks[5], (DEPTH, 2, D), jnp.float32),
        'gm_w_in': nrm(ks[6], (N_GM, D, 2 * GM_WIDTH), jnp.float32) * D ** -0.5,
        'gm_ln_g': 1.0 + 0.02 * nrm(ks[7], (N_GM, GM_WIDTH), jnp.float32),
        'gm_ln_b': 0.02 * nrm(ks[8], (N_GM, GM_WIDTH), jnp.float32),
        'gm_w_s': nrm(ks[9], (N_GM, GM_GROUPS, CHUNK, CHUNK), jnp.float32) * CHUNK ** -0.5,
        'gm_b_s': 1.0 + 0.1 * nrm(ks[10], (N_GM, GM_GROUPS, CHUNK), jnp.float32),
        'gm_w_out': nrm(ks[11], (N_GM, GM_WIDTH, D), jnp.float32) * (DN_BETA * GM_WIDTH ** -0.5),
        'fox_w_in': nrm(ks[12], (N_FOX, D, 3 * D + FOX_HEADS), jnp.float32) * D ** -0.5,
        'fox_b_f': jax.random.uniform(ks[13], (N_FOX, FOX_HEADS), jnp.float32, 1.0, 4.0),
        'fox_w_out': nrm(ks[14], (N_FOX, D, D), jnp.float32) * (DN_BETA * D ** -0.5),
        'pool_w_in': nrm(ks[15], (N_POOL, D, POOL_WIDTH), jnp.float32) * D ** -0.5,
        'pool_w_grp': nrm(ks[16], (N_POOL, POOL_GROUPS, POOL_GROUP_DIM, POOL_GROUP_DIM), jnp.float32) * POOL_GROUP_DIM ** -0.5,
        'pool_scale': 1.0 + 0.1 * nrm(ks[17], (N_POOL, POOL_WIDTH), jnp.float32),
        'pool_w_out': nrm(ks[18], (N_POOL, POOL_WIDTH, D), jnp.float32) * (DN_BETA * POOL_WIDTH ** -0.5),
        'ffn_w13': nrm(ks[19], (N_DENSE, D, 2 * F), jnp.float32) * D ** -0.5,
        'ffn_w2': nrm(ks[20], (N_DENSE, F, D), jnp.float32) * (DN_BETA * F ** -0.5),
        'moe_w_router': nrm(ks[21], (N_MOE, D, E), jnp.float32) * D ** -0.5,
        'moe_b_router': 0.01 * nrm(ks[22], (N_MOE, E), jnp.float32),
        'moe_w13': nrm(ks[23], (N_MOE, E, D, 2 * F), jnp.float32) * D ** -0.5,
        'moe_w2': nrm(jax.random.fold_in(ks[23], 1), (N_MOE, E, F, D), jnp.float32) * (DN_BETA * F ** -0.5),
    }


def reference(x, c, mod_w, mod_b, ln_g, ln_b, gm_w_in, gm_ln_g, gm_ln_b, gm_w_s, gm_b_s, gm_w_out,
              fox_w_in, fox_b_f, fox_w_out, pool_w_in, pool_w_grp, pool_scale, pool_w_out,
              ffn_w13, ffn_w2, moe_w_router, moe_b_router, moe_w13, moe_w2):
    mod = jnp.einsum('bd,ldm->lbm', jax.nn.silu(c), mod_w) + mod_b[:, None, :]
    for i in range(DEPTH):
        sh1, sc1, g1, sh2, sc2, g2 = jnp.split(mod[i][:, None, :], 6, axis=-1)
        h = x * (1 + sc1) + sh1
        kind, j = i % N_MIXERS, i // N_MIXERS
        if kind == 0:
            y = gmlp_chunk_mixer(h, gm_w_in[j], gm_ln_g[j], gm_ln_b[j], gm_w_s[j], gm_b_s[j], gm_w_out[j])
        elif kind == 1:
            y = forgetting_attention(h, fox_w_in[j], fox_b_f[j], fox_w_out[j])
        else:
            y = multiscale_pool_mixer(h, pool_w_in[j], pool_w_grp[j], pool_scale[j], pool_w_out[j])
        x = layer_norm(DN_ALPHA * x + (1 + g1) * y, ln_g[i, 0], ln_b[i, 0])
        h = x * (1 + sc2) + sh2
        if i % 2 == 0:
            y = swiglu(h, ffn_w13[i // 2], ffn_w2[i // 2])
        else:
            y = moe_swiglu(h, moe_w_router[i // 2], moe_b_router[i // 2], moe_w13[i // 2], moe_w2[i // 2])
        x = layer_norm(DN_ALPHA * x + (1 + g2) * y, ln_g[i, 1], ln_b[i, 1])
    return x
```

```cpp
#include <hip/hip_runtime.h>
#include <cstdio>
#include <cstdint>
#include <cstring>

typedef unsigned short bf16;
typedef short bf16x8 __attribute__((ext_vector_type(8)));
typedef float f32x4 __attribute__((ext_vector_type(4)));
typedef unsigned u32x4 __attribute__((ext_vector_type(4)));
typedef unsigned u32x2 __attribute__((ext_vector_type(2)));

constexpr int D = 1024, NB = 2, S = 8192, M = NB * S, DEPTH = 4;
constexpr int GW = 2048, GMG = 8, CH = 128, F = 3584, NE = 8, H = 16, HD = 64;
constexpr float LN_EPS = 1e-5f;
constexpr float DN_ALPHA = 1.6817928305074290860622509524664f;
constexpr float LOG2E = 1.4426950408889634f;
constexpr float QSCALE = 0.125f * LOG2E;

constexpr size_t MiB = 1u << 20;
constexpr size_t WS_CTL = 0;
constexpr size_t WS_MOD = 1 * MiB;
constexpr size_t WS_X = 2 * MiB;
constexpr size_t WS_Y = 66 * MiB;
constexpr size_t WS_H = 130 * MiB;
constexpr size_t WS_Z = 162 * MiB;
constexpr size_t WS_VLN = 290 * MiB;
constexpr size_t WS_G = 354 * MiB;
constexpr size_t WS_ACT = 418 * MiB;
constexpr size_t WS_Q = 658 * MiB;
constexpr size_t WS_AO = 754 * MiB;
constexpr size_t WS_LF = 786 * MiB;
constexpr size_t WS_CUM = 787 * MiB;
constexpr size_t WS_PZ = 788 * MiB;
constexpr size_t WS_PP = 820 * MiB;
constexpr size_t WS_PG = 852 * MiB;
constexpr size_t WS_YS = 884 * MiB;
constexpr size_t WS_RT = 952 * MiB;
constexpr size_t WS_END = 960 * MiB;
constexpr int CW_CNT = 64;

__device__ __forceinline__ unsigned f2bf(float f) { unsigned u = __builtin_bit_cast(unsigned, f); return (u + 0x7fffu + ((u >> 16) & 1u)) >> 16; }
__device__ __forceinline__ float bf2f(unsigned short u) { return __builtin_bit_cast(float, (unsigned)u << 16); }
__device__ __forceinline__ unsigned pk2(float lo, float hi) { return f2bf(lo) | (f2bf(hi) << 16); }
__device__ __forceinline__ float wave_sum(float v) {
#pragma unroll
    for (int o = 1; o < 64; o <<= 1) v += __shfl_xor(v, o);
    return v;
}
__device__ __forceinline__ float wave_max(float v) {
#pragma unroll
    for (int o = 1; o < 64; o <<= 1) v = fmaxf(v, __shfl_xor(v, o));
    return v;
}
__device__ __forceinline__ float silu_f(float v) { return v / (1.f + __expf(-v)); }
__device__ __forceinline__ float gelu_f(float v) { return 0.5f * v * (1.f + erff(v * 0.70710678118654752f)); }

__global__ void __launch_bounds__(256) k_mod(const float* __restrict__ c, const float* __restrict__ mod_w, const float* __restrict__ mod_b, float* __restrict__ MOD) {
    __shared__ float sc[2 * D];
    for (int i = threadIdx.x; i < 2 * D; i += 256) sc[i] = silu_f(c[i]);
    __syncthreads();
    const int idx = blockIdx.x * 256 + threadIdx.x;
    const int l = idx / (6 * D), m = idx % (6 * D);
    const float* w = mod_w + (size_t)l * D * 6 * D + m;
    float a0 = 0.f, a1 = 0.f;
#pragma unroll 8
    for (int d = 0; d < D; ++d) { const float wv = w[(size_t)d * 6 * D]; a0 += sc[d] * wv; a1 += sc[D + d] * wv; }
    const float bb = mod_b[idx];
    MOD[((size_t)l * 2 + 0) * 6 * D + m] = a0 + bb;
    MOD[((size_t)l * 2 + 1) * 6 * D + m] = a1 + bb;
}

__global__ void __launch_bounds__(256) k_modulate(const float* __restrict__ x, const float* __restrict__ MODl, int which_sh, bf16* __restrict__ Hout) {
    const int row = blockIdx.x * 4 + (threadIdx.x >> 6), lane = threadIdx.x & 63, b = row / S;
    const float* sh = MODl + (size_t)b * 6 * D + which_sh * D; const float* sc = sh + D;
#pragma unroll
    for (int i = 0; i < 4; ++i) {
        const int col = lane * 4 + 256 * i;
        const f32x4 xv = *(const f32x4*)(x + (size_t)row * D + col), s1 = *(const f32x4*)(sc + col), s0 = *(const f32x4*)(sh + col);
        const f32x4 h = xv * (1.f + s1) + s0;
        u32x2 w; w.x = pk2(h[0], h[1]); w.y = pk2(h[2], h[3]);
        *(u32x2*)(Hout + (size_t)row * D + col) = w;
    }
}

struct LnArgs {
    const float* xin; const float* y; float* xout; bf16* hout;
    const float* gate;
    const float* gamma; const float* beta;
    const float* nsh;
    const bf16* ys; const int* tok_e; const int* tok_pos; const float* tok_g; const int* cnt;
};
__global__ void __launch_bounds__(256) k_ln(LnArgs a) {
    const int row = blockIdx.x * 4 + (threadIdx.x >> 6), lane = threadIdx.x & 63, b = row / S;
    const float* g = a.gate + (size_t)b * 6 * D;
    f32x4 v[4]; float s = 0.f;
    size_t r0 = 0, r1 = 0; float g0 = 0.f, g1 = 0.f;
    if (a.ys) {
        const int e0 = a.tok_e[row * 2], e1 = a.tok_e[row * 2 + 1];
        int o0 = 0, o1 = 0;
        for (int e = 0; e < NE; ++e) { const int c = a.cnt[e]; if (e < e0) o0 += c; if (e < e1) o1 += c; }
        r0 = (size_t)(o0 + a.tok_pos[row * 2]) * D; r1 = (size_t)(o1 + a.tok_pos[row * 2 + 1]) * D;
        g0 = a.tok_g[row * 2]; g1 = a.tok_g[row * 2 + 1];
    }
#pragma unroll
    for (int i = 0; i < 4; ++i) {
        const int col = lane * 4 + 256 * i;
        const f32x4 xv = *(const f32x4*)(a.xin + (size_t)row * D + col);
        f32x4 yv;
        if (a.ys) {
            const u32x2 w0 = *(const u32x2*)(a.ys + r0 + col), w1 = *(const u32x2*)(a.ys + r1 + col);
            yv[0] = g0 * bf2f(w0.x & 0xffff) + g1 * bf2f(w1.x & 0xffff); yv[1] = g0 * bf2f(w0.x >> 16) + g1 * bf2f(w1.x >> 16);
            yv[2] = g0 * bf2f(w0.y & 0xffff) + g1 * bf2f(w1.y & 0xffff); yv[3] = g0 * bf2f(w0.y >> 16) + g1 * bf2f(w1.y >> 16);
        } else yv = *(const f32x4*)(a.y + (size_t)row * D + col);
        const f32x4 gv = *(const f32x4*)(g + col);
        v[i] = DN_ALPHA * xv + (1.f + gv) * yv;
        s += (v[i][0] + v[i][1]) + (v[i][2] + v[i][3]);
    }
    const float mean = wave_sum(s) * (1.f / D); float s2 = 0.f;
#pragma unroll
    for (int i = 0; i < 4; ++i) { v[i] = v[i] - mean; s2 += (v[i][0] * v[i][0] + v[i][1] * v[i][1]) + (v[i][2] * v[i][2] + v[i][3] * v[i][3]); }
    const float rstd = 1.f / sqrtf(wave_sum(s2) * (1.f / D) + LN_EPS);
#pragma unroll
    for (int i = 0; i < 4; ++i) {
        const int col = lane * 4 + 256 * i;
        const f32x4 o = v[i] * rstd * *(const f32x4*)(a.gamma + col) + *(const f32x4*)(a.beta + col);
        *(f32x4*)(a.xout + (size_t)row * D + col) = o;
        if (a.hout) {
            const float* sh = a.nsh + (size_t)b * 6 * D; const float* sc = sh + D;
            const f32x4 h = o * (1.f + *(const f32x4*)(sc + col)) + *(const f32x4*)(sh + col);
            u32x2 w; w.x = pk2(h[0], h[1]); w.y = pk2(h[2], h[3]);
            *(u32x2*)(a.hout + (size_t)row * D + col) = w;
        }
    }
}

enum { EP_F32 = 0, EP_BF16 = 1, EP_GELU = 2, EP_SWIGLU = 3, EP_QKV = 4 };
struct GF {
    const bf16* A;
    const int* gather;
    const int* cnt;
    const float* B; size_t bz;
    void* out;
    const float* colscale;
    int lda, K, Mrows;
    int a_compact;
    int ldb, mode, ldo;
    int grouped;
};
static_assert(sizeof(GF) == 7 * 8 + 8 * 4, "GF has no padding");
template <int DUMMY> __global__ void __launch_bounds__(256) k_gemm(GF f) {
    const int lane = threadIdx.x & 63, wave = threadIdx.x >> 6, fr = lane & 15, fq = lane >> 4;
    const int z = blockIdx.z, cg = blockIdx.y;
    int nrows = f.Mrows, obase = 0;
    if (f.cnt) { nrows = f.cnt[z]; for (int e = 0; e < z; ++e) obase += f.cnt[e]; }
    const int row0 = blockIdx.x * 64 + wave * 16;
    if (row0 >= nrows) return;
    int r = row0 + fr; const bool rvalid = r < nrows; if (!rvalid) r = nrows - 1;
    size_t arow = (size_t)r;
    if (f.gather) arow = (size_t)f.gather[(size_t)z * M + r]; else if (f.a_compact) arow = (size_t)(obase + r);
    const bf16* ap = f.A + arow * f.lda + fq * 8;
    const float* Bz = f.B + (size_t)z * f.bz;
    int col[4];
#pragma unroll
    for (int t = 0; t < 4; ++t) col[t] = (f.mode == EP_SWIGLU) ? ((t < 2) ? 32 * cg + 16 * t : F + 32 * cg + 16 * (t - 2)) : 64 * cg + 16 * t;
    const float* bp[4];
    if (f.grouped) { const int g = (64 * cg) >> 8; ap += g * 256; Bz += (size_t)g * 256 * 256;
#pragma unroll
        for (int t = 0; t < 4; ++t) bp[t] = Bz + (size_t)(fq * 8) * f.ldb + (col[t] - 256 * g) + fr;
    } else {
#pragma unroll
        for (int t = 0; t < 4; ++t) bp[t] = Bz + (size_t)(fq * 8) * f.ldb + col[t] + fr;
    }
    f32x4 acc[4];
#pragma unroll
    for (int t = 0; t < 4; ++t) acc[t] = (f32x4){0.f, 0.f, 0.f, 0.f};
    const int K = f.K; const size_t ldb = (size_t)f.ldb;
    for (int k0 = 0; k0 < K; k0 += 32) {
        const bf16x8 af = *(const bf16x8*)(ap + k0);
#pragma unroll
        for (int t = 0; t < 4; ++t) {
            bf16x8 bfr;
#pragma unroll
            for (int j = 0; j < 8; ++j) bfr[j] = (short)f2bf(bp[t][(size_t)(k0 + j) * ldb]);
            acc[t] = __builtin_amdgcn_mfma_f32_16x16x32_bf16(bfr, af, acc[t], 0, 0, 0);
        }
    }
    if (!rvalid) return;
    r = row0 + fr;
    const size_t orow = (size_t)(f.cnt ? obase + r : r);
    if (f.mode == EP_SWIGLU) {
#pragma unroll
        for (int t = 0; t < 2; ++t) {
            float o[4];
#pragma unroll
            for (int i = 0; i < 4; ++i) o[i] = silu_f(acc[t][i]) * acc[t + 2][i];
            u32x2 w; w.x = pk2(o[0], o[1]); w.y = pk2(o[2], o[3]);
            *(u32x2*)((bf16*)f.out + orow * f.ldo + 32 * cg + 16 * t + 4 * fq) = w;
        }
        return;
    }
#pragma unroll
    for (int t = 0; t < 4; ++t) {
        const int c = col[t] + 4 * fq;
        f32x4 v = acc[t];
        if (f.mode == EP_F32) { *(f32x4*)((float*)f.out + orow * f.ldo + c) = v; continue; }
        if (f.mode == EP_GELU) { v[0] = gelu_f(v[0]); v[1] = gelu_f(v[1]); v[2] = gelu_f(v[2]); v[3] = gelu_f(v[3]); }
        if (f.colscale) v = v * *(const f32x4*)(f.colscale + c);
        bf16* o = (bf16*)f.out; int cc = c;
        if (f.mode == EP_QKV) { const int which = c >> 10; cc = c & 1023; o += (size_t)which * M * D; if (which == 0) v = v * QSCALE; }
        u32x2 w; w.x = pk2(v[0], v[1]); w.y = pk2(v[2], v[3]);
        *(u32x2*)(o + orow * f.ldo + cc) = w;
    }
}

__global__ void __launch_bounds__(256) k_vln(const bf16* __restrict__ Z, const float* __restrict__ g, const float* __restrict__ bb, bf16* __restrict__ VLN) {
    const int row = blockIdx.x * 4 + (threadIdx.x >> 6), lane = threadIdx.x & 63;
    float v[32]; float s = 0.f;
#pragma unroll
    for (int i = 0; i < 4; ++i) {
        const u32x4 w = *(const u32x4*)(Z + (size_t)row * 4096 + GW + lane * 8 + 512 * i);
#pragma unroll
        for (int j = 0; j < 4; ++j) { v[i * 8 + 2 * j] = bf2f(w[j] & 0xffff); v[i * 8 + 2 * j + 1] = bf2f(w[j] >> 16); }
    }
#pragma unroll
    for (int i = 0; i < 32; ++i) s += v[i];
    const float mean = wave_sum(s) * (1.f / GW); float s2 = 0.f;
#pragma unroll
    for (int i = 0; i < 32; ++i) { v[i] -= mean; s2 += v[i] * v[i]; }
    const float rstd = 1.f / sqrtf(wave_sum(s2) * (1.f / GW) + LN_EPS);
#pragma unroll
    for (int i = 0; i < 4; ++i) {
        const int c0 = lane * 8 + 512 * i; u32x4 w;
#pragma unroll
        for (int j = 0; j < 4; ++j) w[j] = pk2(v[i * 8 + 2 * j] * rstd * g[c0 + 2 * j] + bb[c0 + 2 * j], v[i * 8 + 2 * j + 1] * rstd * g[c0 + 2 * j + 1] + bb[c0 + 2 * j + 1]);
        *(u32x4*)(VLN + (size_t)row * GW + c0) = w;
    }
}
__global__ void __launch_bounds__(128) k_mix(const bf16* __restrict__ Z, const bf16* __restrict__ VLN, const float* __restrict__ ws_, const float* __restrict__ bs, bf16* __restrict__ G) {
    __shared__ bf16 tile[CH * 128];
    const int chunk = blockIdx.x, g = blockIdx.y >> 1, c = (blockIdx.y & 1) * 128 + threadIdx.x, tc = threadIdx.x;
    const size_t row0 = (size_t)chunk * CH;
    for (int s = 0; s < CH; ++s) tile[s * 128 + tc] = VLN[(row0 + s) * GW + g * 256 + c];
    __syncthreads();
    const float* w = ws_ + (size_t)g * CH * CH;
    for (int t = 0; t < CH; ++t) {
        float acc = 0.f;
        for (int s = 0; s <= t; ++s) acc += w[t * CH + s] * bf2f(tile[s * 128 + tc]);
        acc += bs[g * CH + t];
        const float u = bf2f(Z[(row0 + t) * 4096 + g * 256 + c]);
        G[(row0 + t) * GW + g * 256 + c] = (bf16)f2bf(u * acc);
    }
}

__global__ void __launch_bounds__(256) k_flogit(const float* __restrict__ X, const float* __restrict__ MODl, const float* __restrict__ w_in, const float* __restrict__ b_f, float* __restrict__ LF) {
    const int row = blockIdx.x * 4 + (threadIdx.x >> 6), lane = threadIdx.x & 63, b = row / S;
    const float* sh = MODl + (size_t)b * 6 * D; const float* sc = sh + D;
    float acc[16];
#pragma unroll
    for (int j = 0; j < 16; ++j) acc[j] = 0.f;
    for (int i = 0; i < 16; ++i) {
        const int d = lane + 64 * i;
        const float hv = X[(size_t)row * D + d] * (1.f + sc[d]) + sh[d];
        const float* wr = w_in + (size_t)d * (3 * D + H) + 3 * D;
#pragma unroll
        for (int j = 0; j < 16; ++j) acc[j] += hv * wr[j];
    }
#pragma unroll
    for (int j = 0; j < 16; ++j) acc[j] = wave_sum(acc[j]);
    if (lane < 16) {
        float zz = 0.f;
#pragma unroll
        for (int j = 0; j < 16; ++j) if (lane == j) zz = acc[j];
        zz += b_f[lane];
        const float ls = (zz >= 0.f) ? -log1pf(__expf(-zz)) : zz - log1pf(__expf(zz));
        LF[(size_t)row * 16 + lane] = ls;
    }
}
__global__ void __launch_bounds__(64) k_fscan(const float* __restrict__ LF, float* __restrict__ CUM) {
    const int bh = blockIdx.x, b = bh / H, h = bh % H, lane = threadIdx.x;
    const int per = S / 64;
    float s = 0.f;
    for (int i = 0; i < per; ++i) s += LF[((size_t)b * S + lane * per + i) * 16 + h];
    float incl = s;
#pragma unroll
    for (int o = 1; o < 64; o <<= 1) { const float t = __shfl_up(incl, o); if (lane >= o) incl += t; }
    float run = incl - s;
    for (int i = 0; i < per; ++i) { run += LF[((size_t)b * S + lane * per + i) * 16 + h]; CUM[(size_t)bh * S + lane * per + i] = run; }
}
__global__ void __launch_bounds__(256) k_attn(const bf16* __restrict__ Q, const bf16* __restrict__ Kb, const bf16* __restrict__ Vb, const float* __restrict__ CUM, bf16* __restrict__ AO) {
    const int gq = blockIdx.x * 4 + (threadIdx.x >> 6), lane = threadIdx.x & 63;
    const int t = gq % S, bh = gq / S, b = bh / H, h = bh % H;
    const size_t rowb = (size_t)b * S;
    float q[64];
    {
        const bf16* qp = Q + (rowb + t) * D + h * HD;
#pragma unroll
        for (int i = 0; i < 8; ++i) { const u32x4 w = *(const u32x4*)(qp + 8 * i);
#pragma unroll
            for (int j = 0; j < 4; ++j) { q[8 * i + 2 * j] = bf2f(w[j] & 0xffff); q[8 * i + 2 * j + 1] = bf2f(w[j] >> 16); } }
    }
    const float* cum = CUM + (size_t)bh * S;
    const float cq = cum[t] * LOG2E;
    float m = -INFINITY, l = 0.f, o = 0.f;
    for (int kb = 0; kb <= t; kb += 64) {
        const int key = kb + lane; const bool valid = key <= t;
        float s = -INFINITY;
        if (valid) {
            const bf16* kp = Kb + (rowb + key) * D + h * HD; float dot = 0.f;
#pragma unroll
            for (int i = 0; i < 8; ++i) { const u32x4 w = *(const u32x4*)(kp + 8 * i);
#pragma unroll
                for (int j = 0; j < 4; ++j) { dot += q[8 * i + 2 * j] * bf2f(w[j] & 0xffff); dot += q[8 * i + 2 * j + 1] * bf2f(w[j] >> 16); } }
            s = dot + cq - cum[key] * LOG2E;
        }
        const float mnew = fmaxf(m, wave_max(s));
        const float p = valid ? exp2f(s - mnew) : 0.f;
        const float corr = exp2f(m - mnew);
        l = l * corr + wave_sum(p); o *= corr;
        const int nk = (t - kb + 1 < 64) ? (t - kb + 1) : 64;
        for (int j = 0; j < nk; ++j) { const float pj = __shfl(p, j); o += pj * bf2f(Vb[(rowb + kb + j) * D + h * HD + lane]); }
        m = mnew;
    }
    AO[(rowb + t) * D + h * HD + lane] = (bf16)f2bf(o / l);
}

__global__ void __launch_bounds__(256) k_pool(const bf16* __restrict__ PZ, bf16* __restrict__ PP) {
    const size_t idx = (size_t)blockIdx.x * 256 + threadIdx.x;
    const int row = (int)(idx >> 10), col = (int)(idx & 1023), pos = row % S;
    const int win = 2 << (col >> 8);
    const int cntw = (pos + 1 < win) ? pos + 1 : win;
    float s = 0.f;
    for (int j = 0; j < cntw; ++j) s += bf2f(PZ[(size_t)(row - j) * D + col]);
    const float zc = bf2f(PZ[idx]);
    PP[idx] = (bf16)f2bf(s / (float)cntw - zc);
}

__global__ void __launch_bounds__(256) k_route(const float* __restrict__ X, const float* __restrict__ MODl, const float* __restrict__ wr, const float* __restrict__ br,
                                               int* __restrict__ cnt, int* __restrict__ tok_e, float* __restrict__ tok_g, int* __restrict__ tok_pos, int* __restrict__ list) {
    const int row = blockIdx.x * 4 + (threadIdx.x >> 6), lane = threadIdx.x & 63, b = row / S;
    const float* sh = MODl + (size_t)b * 6 * D + 3 * D; const float* sc = sh + D;
    float acc[8];
#pragma unroll
    for (int j = 0; j < 8; ++j) acc[j] = 0.f;
    for (int i = 0; i < 16; ++i) {
        const int d = lane + 64 * i;
        const float hv = X[(size_t)row * D + d] * (1.f + sc[d]) + sh[d];
        const f32x4 w0 = *(const f32x4*)(wr + (size_t)d * 8), w1 = *(const f32x4*)(wr + (size_t)d * 8 + 4);
        acc[0] += hv * w0[0]; acc[1] += hv * w0[1]; acc[2] += hv * w0[2]; acc[3] += hv * w0[3];
        acc[4] += hv * w1[0]; acc[5] += hv * w1[1]; acc[6] += hv * w1[2]; acc[7] += hv * w1[3];
    }
#pragma unroll
    for (int j = 0; j < 8; ++j) acc[j] = wave_sum(acc[j]) + br[j];
    if (lane == 0) {
        int e0 = 0; float v0 = acc[0];
#pragma unroll
        for (int j = 1; j < 8; ++j) if (acc[j] > v0) { v0 = acc[j]; e0 = j; }
        int e1 = -1; float v1 = -INFINITY;
#pragma unroll
        for (int j = 0; j < 8; ++j) if (j != e0 && acc[j] > v1) { v1 = acc[j]; e1 = j; }
        const float ex = __expf(v1 - v0), g0 = 1.f / (1.f + ex), g1 = ex / (1.f + ex);
        const int p0 = atomicAdd(&cnt[e0], 1), p1 = atomicAdd(&cnt[e1], 1);
        tok_e[row * 2] = e0; tok_e[row * 2 + 1] = e1; tok_g[row * 2] = g0; tok_g[row * 2 + 1] = g1; tok_pos[row * 2] = p0; tok_pos[row * 2 + 1] = p1;
        list[(size_t)e0 * M + p0] = row; list[(size_t)e1 * M + p1] = row;
    }
}

static void launch_gemm(const GF& f, int ncg, int nz, hipStream_t st) {
    dim3 grid((f.Mrows + 63) / 64, ncg, nz);
    hipLaunchKernelGGL(k_gemm<0>, grid, dim3(256), 0, st, f);
}
extern "C" void kernel_launch(void* const* d_in, const int* in_sizes, int n_in, void* d_out, int out_size, void* d_ws, size_t ws_size, hipStream_t stream) {
    if (n_in != 25 || ws_size < WS_END || out_size != M * D) { fprintf(stderr, "kernel_launch: unexpected shapes (n_in %d, ws %zu, out %d)\n", n_in, ws_size, out_size); return; }
    const float* x = (const float*)d_in[0]; const float* c = (const float*)d_in[1]; const float* mod_w = (const float*)d_in[2]; const float* mod_b = (const float*)d_in[3];
    const float* ln_g = (const float*)d_in[4]; const float* ln_b = (const float*)d_in[5];
    const float* gm_w_in = (const float*)d_in[6]; const float* gm_ln_g = (const float*)d_in[7]; const float* gm_ln_b = (const float*)d_in[8];
    const float* gm_w_s = (const float*)d_in[9]; const float* gm_b_s = (const float*)d_in[10]; const float* gm_w_out = (const float*)d_in[11];
    const float* fox_w_in = (const float*)d_in[12]; const float* fox_b_f = (const float*)d_in[13]; const float* fox_w_out = (const float*)d_in[14];
    const float* pool_w_in = (const float*)d_in[15]; const float* pool_w_grp = (const float*)d_in[16]; const float* pool_scale = (const float*)d_in[17]; const float* pool_w_out = (const float*)d_in[18];
    const float* ffn_w13 = (const float*)d_in[19]; const float* ffn_w2 = (const float*)d_in[20];
    const float* moe_wr = (const float*)d_in[21]; const float* moe_br = (const float*)d_in[22]; const float* moe_w13 = (const float*)d_in[23]; const float* moe_w2 = (const float*)d_in[24];
    unsigned char* ws = (unsigned char*)d_ws;
    int* ctl = (int*)(ws + WS_CTL); float* MOD = (float*)(ws + WS_MOD); float* X = (float*)(ws + WS_X); float* Y = (float*)(ws + WS_Y);
    bf16* Hb = (bf16*)(ws + WS_H); bf16* Z = (bf16*)(ws + WS_Z); bf16* VLN = (bf16*)(ws + WS_VLN); bf16* G = (bf16*)(ws + WS_G); bf16* ACT = (bf16*)(ws + WS_ACT);
    bf16* Qb = (bf16*)(ws + WS_Q); bf16* Kb = Qb + (size_t)M * D; bf16* Vb = Kb + (size_t)M * D; bf16* AO = (bf16*)(ws + WS_AO);
    float* LF = (float*)(ws + WS_LF); float* CUM = (float*)(ws + WS_CUM);
    bf16* PZ = (bf16*)(ws + WS_PZ); bf16* PP = (bf16*)(ws + WS_PP); bf16* PG = (bf16*)(ws + WS_PG); bf16* YS = (bf16*)(ws + WS_YS);
    int* tok_e = (int*)(ws + WS_RT); float* tok_g = (float*)(ws + WS_RT + 128 * 1024); int* tok_pos = (int*)(ws + WS_RT + 256 * 1024); int* list = (int*)(ws + WS_RT + 512 * 1024);

    hipMemsetAsync(ws + WS_CTL, 0, 4096, stream);
    hipLaunchKernelGGL(k_mod, dim3(DEPTH * 6 * D / 256), dim3(256), 0, stream, c, mod_w, mod_b, MOD);
    hipLaunchKernelGGL(k_modulate, dim3(M / 4), dim3(256), 0, stream, x, MOD, 0, Hb);
    const float* xcur = x;
    for (int i = 0; i < DEPTH; ++i) {
        const float* MODl = MOD + (size_t)i * 2 * 6 * D;
        const int kind = i % 3, j = i / 3;
        if (kind == 0) {
            GF f; memset(&f, 0, sizeof f); f.A = Hb; f.lda = D; f.K = D; f.Mrows = M; f.B = gm_w_in + (size_t)j * D * 4096; f.ldb = 4096; f.mode = EP_GELU; f.out = Z; f.ldo = 4096;
            launch_gemm(f, 4096 / 64, 1, stream);
            hipLaunchKernelGGL(k_vln, dim3(M / 4), dim3(256), 0, stream, Z, gm_ln_g + (size_t)j * GW, gm_ln_b + (size_t)j * GW, VLN);
            hipLaunchKernelGGL(k_mix, dim3(M / CH, GMG * 2), dim3(128), 0, stream, Z, VLN, gm_w_s + (size_t)j * GMG * CH * CH, gm_b_s + (size_t)j * GMG * CH, G);
            GF f2; memset(&f2, 0, sizeof f2); f2.A = G; f2.lda = GW; f2.K = GW; f2.Mrows = M; f2.B = gm_w_out + (size_t)j * GW * D; f2.ldb = D; f2.mode = EP_F32; f2.out = Y; f2.ldo = D;
            launch_gemm(f2, D / 64, 1, stream);
        } else if (kind == 1) {
            GF f; memset(&f, 0, sizeof f); f.A = Hb; f.lda = D; f.K = D; f.Mrows = M; f.B = fox_w_in + (size_t)j * D * (3 * D + H); f.ldb = 3 * D + H; f.mode = EP_QKV; f.out = Qb; f.ldo = D;
            launch_gemm(f, 3 * D / 64, 1, stream);
            hipLaunchKernelGGL(k_flogit, dim3(M / 4), dim3(256), 0, stream, xcur, MODl, fox_w_in + (size_t)j * D * (3 * D + H), fox_b_f + (size_t)j * H, LF);
            hipLaunchKernelGGL(k_fscan, dim3(NB * H), dim3(64), 0, stream, LF, CUM);
            hipLaunchKernelGGL(k_attn, dim3(NB * H * S / 4), dim3(256), 0, stream, Qb, Kb, Vb, CUM, AO);
            GF f2; memset(&f2, 0, sizeof f2); f2.A = AO; f2.lda = D; f2.K = D; f2.Mrows = M; f2.B = fox_w_out + (size_t)j * D * D; f2.ldb = D; f2.mode = EP_F32; f2.out = Y; f2.ldo = D;
            launch_gemm(f2, D / 64, 1, stream);
        } else {
            GF f; memset(&f, 0, sizeof f); f.A = Hb; f.lda = D; f.K = D; f.Mrows = M; f.B = pool_w_in + (size_t)j * D * D; f.ldb = D; f.mode = EP_BF16; f.out = PZ; f.ldo = D;
            launch_gemm(f, D / 64, 1, stream);
            hipLaunchKernelGGL(k_pool, dim3(M * D / 256), dim3(256), 0, stream, PZ, PP);
            GF f1; memset(&f1, 0, sizeof f1); f1.A = PP; f1.lda = D; f1.K = 256; f1.Mrows = M; f1.B = pool_w_grp + (size_t)j * 4 * 256 * 256; f1.ldb = 256; f1.mode = EP_BF16; f1.out = PG; f1.ldo = D;
            f1.colscale = pool_scale + (size_t)j * D; f1.grouped = 1;
            launch_gemm(f1, D / 64, 1, stream);
            GF f2; memset(&f2, 0, sizeof f2); f2.A = PG; f2.lda = D; f2.K = D; f2.Mrows = M; f2.B = pool_w_out + (size_t)j * D * D; f2.ldb = D; f2.mode = EP_F32; f2.out = Y; f2.ldo = D;
            launch_gemm(f2, D / 64, 1, stream);
        }
        {
            LnArgs a; memset(&a, 0, sizeof a); a.xin = xcur; a.y = Y; a.xout = X; a.hout = Hb; a.gate = MODl + 2 * D; a.gamma = ln_g + (size_t)(i * 2) * D; a.beta = ln_b + (size_t)(i * 2) * D; a.nsh = MODl + 3 * D;
            hipLaunchKernelGGL(k_ln, dim3(M / 4), dim3(256), 0, stream, a);
            xcur = X;
        }
        const bool last = (i == DEPTH - 1);
        const float* MODn = MOD + (size_t)(i + 1) * 2 * 6 * D;
        if (i % 2 == 0) {
            const int fi = i / 2;
            GF f; memset(&f, 0, sizeof f); f.A = Hb; f.lda = D; f.K = D; f.Mrows = M; f.B = ffn_w13 + (size_t)fi * D * 2 * F; f.ldb = 2 * F; f.mode = EP_SWIGLU; f.out = ACT; f.ldo = F;
            launch_gemm(f, F / 32, 1, stream);
            GF f2; memset(&f2, 0, sizeof f2); f2.A = ACT; f2.lda = F; f2.K = F; f2.Mrows = M; f2.B = ffn_w2 + (size_t)fi * F * D; f2.ldb = D; f2.mode = EP_F32; f2.out = Y; f2.ldo = D;
            launch_gemm(f2, D / 64, 1, stream);
            LnArgs a; memset(&a, 0, sizeof a); a.xin = X; a.y = Y; a.xout = last ? (float*)d_out : X; a.hout = last ? nullptr : Hb; a.gate = MODl + 5 * D; a.gamma = ln_g + (size_t)(i * 2 + 1) * D; a.beta = ln_b + (size_t)(i * 2 + 1) * D; a.nsh = last ? nullptr : MODn;
            hipLaunchKernelGGL(k_ln, dim3(M / 4), dim3(256), 0, stream, a);
        } else {
            const int mi = i / 2; int* cnt = ctl + CW_CNT + 16 * mi;
            hipLaunchKernelGGL(k_route, dim3(M / 4), dim3(256), 0, stream, X, MODl, moe_wr + (size_t)mi * D * NE, moe_br + (size_t)mi * NE, cnt, tok_e, tok_g, tok_pos, list);
            GF f; memset(&f, 0, sizeof f); f.A = Hb; f.lda = D; f.K = D; f.Mrows = M; f.gather = list; f.cnt = cnt; f.B = moe_w13 + (size_t)mi * NE * D * 2 * F; f.ldb = 2 * F; f.bz = (size_t)D * 2 * F; f.mode = EP_SWIGLU; f.out = ACT; f.ldo = F;
            launch_gemm(f, F / 32, NE, stream);
            GF f2; memset(&f2, 0, sizeof f2); f2.A = ACT; f2.lda = F; f2.K = F; f2.Mrows = M; f2.cnt = cnt; f2.a_compact = 1; f2.B = moe_w2 + (size_t)mi * NE * F * D; f2.ldb = D; f2.bz = (size_t)F * D; f2.mode = EP_BF16; f2.out = YS; f2.ldo = D;
            launch_gemm(f2, D / 64, NE, stream);
            LnArgs a; memset(&a, 0, sizeof a); a.xin = X; a.xout = last ? (float*)d_out : X; a.hout = last ? nullptr : Hb; a.gate = MODl + 5 * D; a.gamma = ln_g + (size_t)(i * 2 + 1) * D; a.beta = ln_b + (size_t)(i * 2 + 1) * D; a.nsh = last ? nullptr : MODn;
            a.ys = YS; a.tok_e = tok_e; a.tok_pos = tok_pos; a.tok_g = tok_g; a.cnt = cnt;
            hipLaunchKernelGGL(k_ln, dim3(M / 4), dim3(256), 0, stream, a);
        }
    }
}
```

```cpp
#include <hip/hip_runtime.h>
#include <cstdio>
#include <cstdint>
#include <cstring>

typedef unsigned short bf16;
typedef short bf16x8 __attribute__((ext_vector_type(8)));
typedef float f32x4 __attribute__((ext_vector_type(4)));
typedef unsigned u32x4 __attribute__((ext_vector_type(4)));
typedef unsigned u32x2 __attribute__((ext_vector_type(2)));

constexpr int D = 1024, NB = 2, S = 8192, M = NB * S, DEPTH = 4;
constexpr int GW = 2048, GMG = 8, CH = 128, F = 3584, NE = 8, H = 16, HD = 64;
constexpr float LN_EPS = 1e-5f;
constexpr float DN_ALPHA = 1.6817928305074290860622509524664f;
constexpr float LOG2E = 1.4426950408889634f;
constexpr float QSCALE = 0.125f * LOG2E;

constexpr size_t MiB = 1u << 20;
constexpr size_t WS_CTL = 0;
constexpr size_t WS_MOD = 1 * MiB;
constexpr size_t WS_X = 2 * MiB;
constexpr size_t WS_Y = 66 * MiB;
constexpr size_t WS_H = 130 * MiB;
constexpr size_t WS_Z = 162 * MiB;
constexpr size_t WS_VLN = 290 * MiB;
constexpr size_t WS_G = 354 * MiB;
constexpr size_t WS_ACT = 418 * MiB;
constexpr size_t WS_Q = 658 * MiB;
constexpr size_t WS_AO = 754 * MiB;
constexpr size_t WS_LF = 786 * MiB;
constexpr size_t WS_CUM = 787 * MiB;
constexpr size_t WS_PZ = 788 * MiB;
constexpr size_t WS_PP = 820 * MiB;
constexpr size_t WS_PG = 852 * MiB;
constexpr size_t WS_YS = 884 * MiB;
constexpr size_t WS_RT = 952 * MiB;
constexpr size_t WS_END = 960 * MiB;
constexpr int CW_CNT = 64;

__device__ __forceinline__ unsigned f2bf(float f) { unsigned u = __builtin_bit_cast(unsigned, f); return (u + 0x7fffu + ((u >> 16) & 1u)) >> 16; }
__device__ __forceinline__ float bf2f(unsigned short u) { return __builtin_bit_cast(float, (unsigned)u << 16); }
__device__ __forceinline__ unsigned pk2(float lo, float hi) { return f2bf(lo) | (f2bf(hi) << 16); }
__device__ __forceinline__ float wave_sum(float v) {
#pragma unroll
    for (int o = 1; o < 64; o <<= 1) v += __shfl_xor(v, o);
    return v;
}
__device__ __forceinline__ float wave_max(float v) {
#pragma unroll
    for (int o = 1; o < 64; o <<= 1) v = fmaxf(v, __shfl_xor(v, o));
    return v;
}
__device__ __forceinline__ float silu_f(float v) { return v / (1.f + __expf(-v)); }
__device__ __forceinline__ float gelu_f(float v) { return 0.5f * v * (1.f + erff(v * 0.70710678118654752f)); }


#define GAS __attribute__((address_space(1)))
#define LAS __attribute__((address_space(3)))
typedef GAS unsigned gu32;
#define RLX_AGENT __ATOMIC_RELAXED, __HIP_MEMORY_SCOPE_AGENT
constexpr int NWAVES = 8;
constexpr int CW_BAR = 4096;
constexpr size_t CTL_ZERO_BYTES = 64 * 1024;
constexpr int LDS_BYTES = 147456;
constexpr int MISC_OFF = 131072 + 320;

#define XB_TMO      128
#define XB_XCNT(j)  (256  + 64 * (j))
#define XB_XSUB(j)  (1280 + 64 * (j))
#define XB_XGEN(j)  (2304 + 64 * (j))
#define XB_TOP      3328
#define XB_TOPGEN   3392
#define XCD_BAR_WORDS 3456
#define XB_SPIN_CAP (1u << 21)

__device__ __forceinline__ unsigned xb_ld(unsigned* p)              { return __hip_atomic_load(p, __ATOMIC_RELAXED, __HIP_MEMORY_SCOPE_AGENT); }
__device__ __forceinline__ unsigned xb_add(unsigned* p, unsigned v) { return __hip_atomic_fetch_add(p, v, __ATOMIC_RELAXED, __HIP_MEMORY_SCOPE_AGENT); }
__device__ __forceinline__ unsigned xb_xcc_id() { return (unsigned)__builtin_amdgcn_s_getreg((3 << 11) | 20) & 0xFu; }
#define XB_SPIN(cond, bar) do { unsigned _sp = 0; while (cond) { __builtin_amdgcn_s_sleep(1); \
    if ((++_sp & 255u) == 0u) { if (xb_ld(&(bar)[XB_TMO])) break; if (_sp > XB_SPIN_CAP) { atomicAdd(&(bar)[XB_TMO], 1u); break; } } } } while (0)

struct XcdBarrier {
    unsigned* bar; unsigned x;
    volatile LAS unsigned* st;
};

__device__ __forceinline__ XcdBarrier xcd_barrier_post(unsigned* bar, volatile LAS unsigned* st) {
    XcdBarrier b; b.bar = bar; b.x = xb_xcc_id(); b.st = st;
    if (threadIdx.x == 0) (void)xb_add(&bar[XB_XCNT(b.x)], 1u);
    return b;
}
__device__ __forceinline__ void xcd_barrier_complete(unsigned* bar, unsigned x, unsigned& nloc, unsigned& nx) {
    const unsigned G = gridDim.x * gridDim.y * gridDim.z;
    unsigned sum, cnt, mine, sp = 0u;
    for (;;) {
        sum = 0u; cnt = 0u; mine = 0u;
#pragma unroll
        for (unsigned j = 0; j < 16; ++j) { const unsigned c = xb_ld(&bar[XB_XCNT(j)]); sum += c; cnt += (c > 0u) ? 1u : 0u; mine = (j == x) ? c : mine; }
        if (sum == G) break;
        __builtin_amdgcn_s_sleep(1);
        if ((++sp & 255u) == 0u) { if (xb_ld(&bar[XB_TMO])) break; if (sp > XB_SPIN_CAP) { atomicAdd(&bar[XB_TMO], 1u); break; } }
    }
    nloc = mine > 0u ? mine : 1u; nx = cnt > 0u ? cnt : 1u;
}

__device__ __forceinline__ void xcd_barrier(const XcdBarrier& b) {
    asm volatile("s_waitcnt vmcnt(0)" ::: "memory");
    __syncthreads();
    if (threadIdx.x == 0) {
        unsigned* bar = b.bar;
        __builtin_amdgcn_s_waitcnt(0);
        unsigned nloc = b.st[0], nx = b.st[1];
        if (nloc == 0u) { xcd_barrier_complete(bar, b.x, nloc, nx); b.st[0] = nloc; b.st[1] = nx; }
        const unsigned old = xb_add(&bar[XB_XSUB(b.x)], 1u);
        const unsigned gen = old / nloc;
        if (old + 1u == (gen + 1u) * nloc) {
            __builtin_amdgcn_fence(__ATOMIC_RELEASE, "agent");
            asm volatile("s_waitcnt vmcnt(0)" ::: "memory");
            const unsigned og = xb_add(&bar[XB_TOP], 1u);
            const unsigned tg = og / nx;
            if (og + 1u == (tg + 1u) * nx) xb_add(&bar[XB_TOPGEN], 1u);
            else XB_SPIN(xb_ld(&bar[XB_TOPGEN]) == tg, bar);
            __builtin_amdgcn_fence(__ATOMIC_ACQUIRE, "agent");
            xb_add(&bar[XB_XGEN(b.x)], 1u);
            asm volatile("s_waitcnt vmcnt(0)" ::: "memory");
        } else {
            XB_SPIN(xb_ld(&bar[XB_XGEN(b.x)]) == gen, bar);
            __builtin_amdgcn_fence(__ATOMIC_ACQUIRE, "agent");
            asm volatile("s_waitcnt vmcnt(0)" ::: "memory");
        }
    }
    __syncthreads();
}


struct Args { const float* in[25]; float* out; unsigned char* ws; };
static_assert(sizeof(Args) == 27 * 8, "Args has no padding");

struct Ctx { int gw, NGW, lane, wave, tid; LAS unsigned char* lds; };

__device__ __forceinline__ void ph_mod(const Ctx& C, const float* __restrict__ c, const float* __restrict__ mod_w, const float* __restrict__ mod_b, float* __restrict__ MOD) {
    LAS float* red = (LAS float*)C.lds;
    for (int it = blockIdx.x; it < DEPTH * 6 * D / 64; it += gridDim.x) {
        const int idx = it * 64 + C.lane, l = idx / (6 * D), m = idx % (6 * D);
        const float* w = mod_w + (size_t)l * D * 6 * D + m;
        float a0 = 0.f, a1 = 0.f;
        const int d0 = C.wave * 128;
#pragma unroll 16
        for (int d = d0; d < d0 + 128; ++d) { const float wv = w[(size_t)d * 6 * D]; a0 += silu_f(c[d]) * wv; a1 += silu_f(c[D + d]) * wv; }
        red[(C.wave * 2 + 0) * 64 + C.lane] = a0; red[(C.wave * 2 + 1) * 64 + C.lane] = a1;
        __syncthreads();
        if (C.wave < 2) {
            float s = 0.f;
#pragma unroll
            for (int w8 = 0; w8 < 8; ++w8) s += red[(w8 * 2 + C.wave) * 64 + C.lane];
            MOD[((size_t)l * 2 + C.wave) * 6 * D + m] = s + mod_b[idx];
        }
        __syncthreads();
    }
}

__device__ __forceinline__ void ph_modulate(const Ctx& C, const float* __restrict__ x, const float* __restrict__ MODl, bf16* __restrict__ Hout) {
    for (int row = C.gw; row < M; row += C.NGW) {
        const int lane = C.lane, b = row / S;
        const float* sh = MODl + (size_t)b * 6 * D; const float* sc = sh + D;
#pragma unroll
        for (int i = 0; i < 4; ++i) {
            const int col = lane * 4 + 256 * i;
            const f32x4 xv = *(const f32x4*)(x + (size_t)row * D + col), s1 = *(const f32x4*)(sc + col), s0 = *(const f32x4*)(sh + col);
            const f32x4 h = xv * (1.f + s1) + s0;
            u32x2 w; w.x = pk2(h[0], h[1]); w.y = pk2(h[2], h[3]);
            *(u32x2*)(Hout + (size_t)row * D + col) = w;
        }
    }
}

struct LnArgs {
    const float* xin; const float* y; float* xout; bf16* hout;
    const float* gate;
    const float* gamma; const float* beta;
    const float* nsh;
    const bf16* ys; const int* tok_e; const int* tok_pos; const float* tok_g; const int* cnt;
};
__device__ __forceinline__ void ph_ln(const Ctx& C, const LnArgs& a) {
    for (int row = C.gw; row < M; row += C.NGW) {
        const int lane = C.lane, b = row / S;
        const float* g = a.gate + (size_t)b * 6 * D;
        f32x4 v[4]; float s = 0.f;
        size_t r0 = 0, r1 = 0; float g0 = 0.f, g1 = 0.f;
        if (a.ys) {
            const int e0 = a.tok_e[row * 2], e1 = a.tok_e[row * 2 + 1];
            int o0 = 0, o1 = 0;
            for (int e = 0; e < NE; ++e) { const int c = a.cnt[e]; if (e < e0) o0 += c; if (e < e1) o1 += c; }
            r0 = (size_t)(o0 + a.tok_pos[row * 2]) * D; r1 = (size_t)(o1 + a.tok_pos[row * 2 + 1]) * D;
            g0 = a.tok_g[row * 2]; g1 = a.tok_g[row * 2 + 1];
        }
#pragma unroll
        for (int i = 0; i < 4; ++i) {
            const int col = lane * 4 + 256 * i;
            const f32x4 xv = *(const f32x4*)(a.xin + (size_t)row * D + col);
            f32x4 yv;
            if (a.ys) {
                const u32x2 w0 = *(const u32x2*)(a.ys + r0 + col), w1 = *(const u32x2*)(a.ys + r1 + col);
                yv[0] = g0 * bf2f(w0.x & 0xffff) + g1 * bf2f(w1.x & 0xffff); yv[1] = g0 * bf2f(w0.x >> 16) + g1 * bf2f(w1.x >> 16);
                yv[2] = g0 * bf2f(w0.y & 0xffff) + g1 * bf2f(w1.y & 0xffff); yv[3] = g0 * bf2f(w0.y >> 16) + g1 * bf2f(w1.y >> 16);
            } else yv = *(const f32x4*)(a.y + (size_t)row * D + col);
            const f32x4 gv = *(const f32x4*)(g + col);
            v[i] = DN_ALPHA * xv + (1.f + gv) * yv;
            s += (v[i][0] + v[i][1]) + (v[i][2] + v[i][3]);
        }
        const float mean = wave_sum(s) * (1.f / D); float s2 = 0.f;
#pragma unroll
        for (int i = 0; i < 4; ++i) { v[i] = v[i] - mean; s2 += (v[i][0] * v[i][0] + v[i][1] * v[i][1]) + (v[i][2] * v[i][2] + v[i][3] * v[i][3]); }
        const float rstd = 1.f / sqrtf(wave_sum(s2) * (1.f / D) + LN_EPS);
#pragma unroll
        for (int i = 0; i < 4; ++i) {
            const int col = lane * 4 + 256 * i;
            const f32x4 o = v[i] * rstd * *(const f32x4*)(a.gamma + col) + *(const f32x4*)(a.beta + col);
            *(f32x4*)(a.xout + (size_t)row * D + col) = o;
            if (a.hout) {
                const float* sh = a.nsh + (size_t)b * 6 * D; const float* sc = sh + D;
                const f32x4 h = o * (1.f + *(const f32x4*)(sc + col)) + *(const f32x4*)(sh + col);
                u32x2 w; w.x = pk2(h[0], h[1]); w.y = pk2(h[2], h[3]);
                *(u32x2*)(a.hout + (size_t)row * D + col) = w;
            }
        }
    }
}

enum { EP_F32 = 0, EP_BF16 = 1, EP_GELU = 2, EP_SWIGLU = 3, EP_QKV = 4 };
struct GF {
    const bf16* A;
    const int* gather;
    const int* cnt;
    const float* B; size_t bz;
    void* out;
    const float* colscale;
    int lda, K, Mrows;
    int a_compact;
    int ldb, mode, ldo;
    int grouped;
};
__device__ __forceinline__ void ph_gemm(const Ctx& C, const GF& f, int ncg, int nz) {
    const int lane = C.lane, fr = lane & 15, fq = lane >> 4;
    const int nrg = f.Mrows / 16;
    const long total = (long)nrg * ncg * nz;
    for (long item = C.gw; item < total; item += C.NGW) {
        const int rg = (int)(item % nrg), cg = (int)((item / nrg) % ncg), z = (int)(item / ((long)nrg * ncg));
        int nrows = f.Mrows, obase = 0;
        if (f.cnt) { nrows = f.cnt[z]; for (int e = 0; e < z; ++e) obase += f.cnt[e]; }
        const int row0 = rg * 16;
        if (row0 >= nrows) continue;
        int r = row0 + fr; const bool rvalid = r < nrows; if (!rvalid) r = nrows - 1;
        size_t arow = (size_t)r;
        if (f.gather) arow = (size_t)f.gather[(size_t)z * M + r]; else if (f.a_compact) arow = (size_t)(obase + r);
        const bf16* ap = f.A + arow * f.lda + fq * 8;
        const float* Bz = f.B + (size_t)z * f.bz;
        int col[4];
#pragma unroll
        for (int t = 0; t < 4; ++t) col[t] = (f.mode == EP_SWIGLU) ? ((t < 2) ? 32 * cg + 16 * t : F + 32 * cg + 16 * (t - 2)) : 64 * cg + 16 * t;
        const float* bp[4];
        if (f.grouped) { const int g = (64 * cg) >> 8; ap += g * 256; Bz += (size_t)g * 256 * 256;
#pragma unroll
            for (int t = 0; t < 4; ++t) bp[t] = Bz + (size_t)(fq * 8) * f.ldb + (col[t] - 256 * g) + fr;
        } else {
#pragma unroll
            for (int t = 0; t < 4; ++t) bp[t] = Bz + (size_t)(fq * 8) * f.ldb + col[t] + fr;
        }
        f32x4 acc[4];
#pragma unroll
        for (int t = 0; t < 4; ++t) acc[t] = (f32x4){0.f, 0.f, 0.f, 0.f};
        const int K = f.K; const size_t ldb = (size_t)f.ldb;
        for (int k0 = 0; k0 < K; k0 += 32) {
            const bf16x8 af = *(const bf16x8*)(ap + k0);
#pragma unroll
            for (int t = 0; t < 4; ++t) {
                bf16x8 bfr;
#pragma unroll
                for (int j = 0; j < 8; ++j) bfr[j] = (short)f2bf(bp[t][(size_t)(k0 + j) * ldb]);
                acc[t] = __builtin_amdgcn_mfma_f32_16x16x32_bf16(bfr, af, acc[t], 0, 0, 0);
            }
        }
        if (!rvalid) continue;
        r = row0 + fr;
        const size_t orow = (size_t)(f.cnt ? obase + r : r);
        if (f.mode == EP_SWIGLU) {
#pragma unroll
            for (int t = 0; t < 2; ++t) {
                float o[4];
#pragma unroll
                for (int i = 0; i < 4; ++i) o[i] = silu_f(acc[t][i]) * acc[t + 2][i];
                u32x2 w; w.x = pk2(o[0], o[1]); w.y = pk2(o[2], o[3]);
                *(u32x2*)((bf16*)f.out + orow * f.ldo + 32 * cg + 16 * t + 4 * fq) = w;
            }
            continue;
        }
#pragma unroll
        for (int t = 0; t < 4; ++t) {
            const int c = col[t] + 4 * fq;
            f32x4 v = acc[t];
            if (f.mode == EP_F32) { *(f32x4*)((float*)f.out + orow * f.ldo + c) = v; continue; }
            if (f.mode == EP_GELU) { v[0] = gelu_f(v[0]); v[1] = gelu_f(v[1]); v[2] = gelu_f(v[2]); v[3] = gelu_f(v[3]); }
            if (f.colscale) v = v * *(const f32x4*)(f.colscale + c);
            bf16* o = (bf16*)f.out; int cc = c;
            if (f.mode == EP_QKV) { const int which = c >> 10; cc = c & 1023; o += (size_t)which * M * D; if (which == 0) v = v * QSCALE; }
            u32x2 w; w.x = pk2(v[0], v[1]); w.y = pk2(v[2], v[3]);
            *(u32x2*)(o + orow * f.ldo + cc) = w;
        }
    }
}

__device__ __forceinline__ void ph_vln(const Ctx& C, const bf16* __restrict__ Z, const float* __restrict__ g, const float* __restrict__ bb, bf16* __restrict__ VLN) {
    for (int row = C.gw; row < M; row += C.NGW) {
        const int lane = C.lane;
        float v[32]; float s = 0.f;
#pragma unroll
        for (int i = 0; i < 4; ++i) {
            const u32x4 w = *(const u32x4*)(Z + (size_t)row * 4096 + GW + lane * 8 + 512 * i);
#pragma unroll
            for (int j = 0; j < 4; ++j) { v[i * 8 + 2 * j] = bf2f(w[j] & 0xffff); v[i * 8 + 2 * j + 1] = bf2f(w[j] >> 16); }
        }
#pragma unroll
        for (int i = 0; i < 32; ++i) s += v[i];
        const float mean = wave_sum(s) * (1.f / GW); float s2 = 0.f;
#pragma unroll
        for (int i = 0; i < 32; ++i) { v[i] -= mean; s2 += v[i] * v[i]; }
        const float rstd = 1.f / sqrtf(wave_sum(s2) * (1.f / GW) + LN_EPS);
#pragma unroll
        for (int i = 0; i < 4; ++i) {
            const int c0 = lane * 8 + 512 * i; u32x4 w;
#pragma unroll
            for (int j = 0; j < 4; ++j) w[j] = pk2(v[i * 8 + 2 * j] * rstd * g[c0 + 2 * j] + bb[c0 + 2 * j], v[i * 8 + 2 * j + 1] * rstd * g[c0 + 2 * j + 1] + bb[c0 + 2 * j + 1]);
            *(u32x4*)(VLN + (size_t)row * GW + c0) = w;
        }
    }
}
__device__ __forceinline__ void ph_mix(const Ctx& C, const bf16* __restrict__ Z, const bf16* __restrict__ VLN, const float* __restrict__ ws_, const float* __restrict__ bs, bf16* __restrict__ G) {
    LAS bf16* tile = (LAS bf16*)C.lds;
    const int c = C.tid & 255, th = C.tid >> 8;
    for (int it = blockIdx.x; it < (M / CH) * GMG; it += gridDim.x) {
        const int chunk = it / GMG, g = it % GMG;
        const size_t row0 = (size_t)chunk * CH;
        for (int s = th * 64; s < th * 64 + 64; ++s) tile[s * 256 + c] = VLN[(row0 + s) * GW + g * 256 + c];
        __syncthreads();
        const float* w = ws_ + (size_t)g * CH * CH;
        for (int t = th * 64; t < th * 64 + 64; ++t) {
            float acc = 0.f;
            for (int s = 0; s <= t; ++s) acc += w[t * CH + s] * bf2f(tile[s * 256 + c]);
            acc += bs[g * CH + t];
            const float u = bf2f(Z[(row0 + t) * 4096 + g * 256 + c]);
            G[(row0 + t) * GW + g * 256 + c] = (bf16)f2bf(u * acc);
        }
        __syncthreads();
    }
}

__device__ __forceinline__ void ph_flogit(const Ctx& C, const float* __restrict__ X, const float* __restrict__ MODl, const float* __restrict__ w_in, const float* __restrict__ b_f, float* __restrict__ LF) {
    for (int row = C.gw; row < M; row += C.NGW) {
        const int lane = C.lane, b = row / S;
        const float* sh = MODl + (size_t)b * 6 * D; const float* sc = sh + D;
        float acc[16];
#pragma unroll
        for (int j = 0; j < 16; ++j) acc[j] = 0.f;
        for (int i = 0; i < 16; ++i) {
            const int d = lane + 64 * i;
            const float hv = X[(size_t)row * D + d] * (1.f + sc[d]) + sh[d];
            const float* wr = w_in + (size_t)d * (3 * D + H) + 3 * D;
#pragma unroll
            for (int j = 0; j < 16; ++j) acc[j] += hv * wr[j];
        }
#pragma unroll
        for (int j = 0; j < 16; ++j) acc[j] = wave_sum(acc[j]);
        if (lane < 16) {
            float zz = 0.f;
#pragma unroll
            for (int j = 0; j < 16; ++j) if (lane == j) zz = acc[j];
            zz += b_f[lane];
            const float ls = (zz >= 0.f) ? -log1pf(__expf(-zz)) : zz - log1pf(__expf(zz));
            LF[(size_t)row * 16 + lane] = ls;
        }
    }
}
__device__ __forceinline__ void ph_fscan(const Ctx& C, const float* __restrict__ LF, float* __restrict__ CUM) {
    for (int bh = C.gw; bh < NB * H; bh += C.NGW) {
        const int b = bh / H, h = bh % H, lane = C.lane;
        const int per = S / 64;
        float s = 0.f;
        for (int i = 0; i < per; ++i) s += LF[((size_t)b * S + lane * per + i) * 16 + h];
        float incl = s;
#pragma unroll
        for (int o = 1; o < 64; o <<= 1) { const float t = __shfl_up(incl, o); if (lane >= o) incl += t; }
        float run = incl - s;
        for (int i = 0; i < per; ++i) { run += LF[((size_t)b * S + lane * per + i) * 16 + h]; CUM[(size_t)bh * S + lane * per + i] = run; }
    }
}
__device__ __forceinline__ void ph_attn(const Ctx& C, const bf16* __restrict__ Q, const bf16* __restrict__ Kb, const bf16* __restrict__ Vb, const float* __restrict__ CUM, bf16* __restrict__ AO) {
    for (int gq = C.gw; gq < NB * H * S; gq += C.NGW) {
        const int lane = C.lane;
        const int t = gq % S, bh = gq / S, b = bh / H, h = bh % H;
        const size_t rowb = (size_t)b * S;
        float q[64];
        {
            const bf16* qp = Q + (rowb + t) * D + h * HD;
#pragma unroll
            for (int i = 0; i < 8; ++i) { const u32x4 w = *(const u32x4*)(qp + 8 * i);
#pragma unroll
                for (int j = 0; j < 4; ++j) { q[8 * i + 2 * j] = bf2f(w[j] & 0xffff); q[8 * i + 2 * j + 1] = bf2f(w[j] >> 16); } }
        }
        const float* cum = CUM + (size_t)bh * S;
        const float cq = cum[t] * LOG2E;
        float m = -INFINITY, l = 0.f, o = 0.f;
        for (int kb = 0; kb <= t; kb += 64) {
            const int key = kb + lane; const bool valid = key <= t;
            float s = -INFINITY;
            if (valid) {
                const bf16* kp = Kb + (rowb + key) * D + h * HD; float dot = 0.f;
#pragma unroll
                for (int i = 0; i < 8; ++i) { const u32x4 w = *(const u32x4*)(kp + 8 * i);
#pragma unroll
                    for (int j = 0; j < 4; ++j) { dot += q[8 * i + 2 * j] * bf2f(w[j] & 0xffff); dot += q[8 * i + 2 * j + 1] * bf2f(w[j] >> 16); } }
                s = dot + cq - cum[key] * LOG2E;
            }
            const float mnew = fmaxf(m, wave_max(s));
            const float p = valid ? exp2f(s - mnew) : 0.f;
            const float corr = exp2f(m - mnew);
            l = l * corr + wave_sum(p); o *= corr;
            const int nk = (t - kb + 1 < 64) ? (t - kb + 1) : 64;
            for (int j = 0; j < nk; ++j) { const float pj = __shfl(p, j); o += pj * bf2f(Vb[(rowb + kb + j) * D + h * HD + lane]); }
            m = mnew;
        }
        AO[(rowb + t) * D + h * HD + lane] = (bf16)f2bf(o / l);
    }
}

__device__ __forceinline__ void ph_pool(const Ctx& C, const bf16* __restrict__ PZ, bf16* __restrict__ PP) {
    const size_t nthr = (size_t)gridDim.x * (NWAVES * 64);
    for (size_t idx = (size_t)blockIdx.x * (NWAVES * 64) + C.tid; idx < (size_t)M * D; idx += nthr) {
        const int row = (int)(idx >> 10), col = (int)(idx & 1023), pos = row % S;
        const int win = 2 << (col >> 8);
        const int cntw = (pos + 1 < win) ? pos + 1 : win;
        float s = 0.f;
        for (int j = 0; j < cntw; ++j) s += bf2f(PZ[(size_t)(row - j) * D + col]);
        const float zc = bf2f(PZ[idx]);
        PP[idx] = (bf16)f2bf(s / (float)cntw - zc);
    }
}

__device__ __forceinline__ void ph_route(const Ctx& C, const float* __restrict__ X, const float* __restrict__ MODl, const float* __restrict__ wr, const float* __restrict__ br,
                                         int* __restrict__ cnt, int* __restrict__ tok_e, float* __restrict__ tok_g, int* __restrict__ tok_pos, int* __restrict__ list) {
    for (int row = C.gw; row < M; row += C.NGW) {
        const int lane = C.lane, b = row / S;
        const float* sh = MODl + (size_t)b * 6 * D + 3 * D; const float* sc = sh + D;
        float acc[8];
#pragma unroll
        for (int j = 0; j < 8; ++j) acc[j] = 0.f;
        for (int i = 0; i < 16; ++i) {
            const int d = lane + 64 * i;
            const float hv = X[(size_t)row * D + d] * (1.f + sc[d]) + sh[d];
            const f32x4 w0 = *(const f32x4*)(wr + (size_t)d * 8), w1 = *(const f32x4*)(wr + (size_t)d * 8 + 4);
            acc[0] += hv * w0[0]; acc[1] += hv * w0[1]; acc[2] += hv * w0[2]; acc[3] += hv * w0[3];
            acc[4] += hv * w1[0]; acc[5] += hv * w1[1]; acc[6] += hv * w1[2]; acc[7] += hv * w1[3];
        }
#pragma unroll
        for (int j = 0; j < 8; ++j) acc[j] = wave_sum(acc[j]) + br[j];
        if (lane == 0) {
            int e0 = 0; float v0 = acc[0];
#pragma unroll
            for (int j = 1; j < 8; ++j) if (acc[j] > v0) { v0 = acc[j]; e0 = j; }
            int e1 = -1; float v1 = -INFINITY;
#pragma unroll
            for (int j = 0; j < 8; ++j) if (j != e0 && acc[j] > v1) { v1 = acc[j]; e1 = j; }
            const float ex = __expf(v1 - v0), g0 = 1.f / (1.f + ex), g1 = ex / (1.f + ex);
            const int p0 = atomicAdd(&cnt[e0], 1), p1 = atomicAdd(&cnt[e1], 1);
            tok_e[row * 2] = e0; tok_e[row * 2 + 1] = e1; tok_g[row * 2] = g0; tok_g[row * 2 + 1] = g1; tok_pos[row * 2] = p0; tok_pos[row * 2 + 1] = p1;
            list[(size_t)e0 * M + p0] = row; list[(size_t)e1 * M + p1] = row;
        }
    }
}

__device__ __forceinline__ GF mkgf(const bf16* A, int lda, int K, const float* B, int ldb, int mode, void* out, int ldo) {
    GF f; f.A = A; f.gather = nullptr; f.cnt = nullptr; f.B = B; f.bz = 0; f.out = out; f.colscale = nullptr; f.lda = lda; f.K = K; f.Mrows = M; f.a_compact = 0; f.ldb = ldb; f.mode = mode; f.ldo = ldo; f.grouped = 0; return f;
}
__global__ void __launch_bounds__(NWAVES * 64, 2) mega_fwd(Args args) {
    extern __shared__ __attribute__((aligned(16))) unsigned char lds_raw[];
    Ctx C; C.tid = threadIdx.x; C.lane = C.tid & 63; C.wave = __builtin_amdgcn_readfirstlane(C.tid >> 6);
    C.gw = blockIdx.x * NWAVES + C.wave; C.NGW = gridDim.x * NWAVES; C.lds = (LAS unsigned char*)lds_raw;
    volatile LAS unsigned* MISC = (volatile LAS unsigned*)(C.lds + MISC_OFF);
    if (C.tid < 32) MISC[C.tid] = 0u;
    __syncthreads();
    unsigned char* ws = args.ws;
    XcdBarrier bar = xcd_barrier_post((unsigned*)(ws + WS_CTL) + CW_BAR, MISC + 8);
#define GRID_BAR() xcd_barrier(bar)

    const float* x = args.in[0]; const float* c = args.in[1]; const float* mod_w = args.in[2]; const float* mod_b = args.in[3];
    const float* ln_g = args.in[4]; const float* ln_b = args.in[5];
    const float* gm_w_in = args.in[6]; const float* gm_ln_g = args.in[7]; const float* gm_ln_b = args.in[8];
    const float* gm_w_s = args.in[9]; const float* gm_b_s = args.in[10]; const float* gm_w_out = args.in[11];
    const float* fox_w_in = args.in[12]; const float* fox_b_f = args.in[13]; const float* fox_w_out = args.in[14];
    const float* pool_w_in = args.in[15]; const float* pool_w_grp = args.in[16]; const float* pool_scale = args.in[17]; const float* pool_w_out = args.in[18];
    const float* ffn_w13 = args.in[19]; const float* ffn_w2 = args.in[20];
    const float* moe_wr = args.in[21]; const float* moe_br = args.in[22]; const float* moe_w13 = args.in[23]; const float* moe_w2 = args.in[24];
    int* ctl = (int*)(ws + WS_CTL); float* MOD = (float*)(ws + WS_MOD); float* X = (float*)(ws + WS_X); float* Y = (float*)(ws + WS_Y);
    bf16* Hb = (bf16*)(ws + WS_H); bf16* Z = (bf16*)(ws + WS_Z); bf16* VLN = (bf16*)(ws + WS_VLN); bf16* G = (bf16*)(ws + WS_G); bf16* ACT = (bf16*)(ws + WS_ACT);
    bf16* Qb = (bf16*)(ws + WS_Q); bf16* Kb = Qb + (size_t)M * D; bf16* Vb = Kb + (size_t)M * D; bf16* AO = (bf16*)(ws + WS_AO);
    float* LF = (float*)(ws + WS_LF); float* CUM = (float*)(ws + WS_CUM);
    bf16* PZ = (bf16*)(ws + WS_PZ); bf16* PP = (bf16*)(ws + WS_PP); bf16* PG = (bf16*)(ws + WS_PG); bf16* YS = (bf16*)(ws + WS_YS);
    int* tok_e = (int*)(ws + WS_RT); float* tok_g = (float*)(ws + WS_RT + 128 * 1024); int* tok_pos = (int*)(ws + WS_RT + 256 * 1024); int* list = (int*)(ws + WS_RT + 512 * 1024);

    ph_mod(C, c, mod_w, mod_b, MOD); GRID_BAR();
    ph_modulate(C, x, MOD, Hb); GRID_BAR();

#define LN_PHASE(i_, sub_, xin_, last_) do { LnArgs a; a.xin = (xin_); a.y = Y; a.xout = (last_) ? args.out : X; a.hout = (last_) ? nullptr : Hb; \
        a.gate = MOD + (size_t)(i_) * 2 * 6 * D + ((sub_) ? 5 : 2) * D; a.gamma = ln_g + (size_t)((i_) * 2 + (sub_)) * D; a.beta = ln_b + (size_t)((i_) * 2 + (sub_)) * D; \
        a.nsh = (sub_) ? MOD + (size_t)((i_) + 1) * 2 * 6 * D : MOD + (size_t)(i_) * 2 * 6 * D + 3 * D; \
        a.ys = nullptr; a.tok_e = nullptr; a.tok_pos = nullptr; a.tok_g = nullptr; a.cnt = nullptr; ph_ln(C, a); GRID_BAR(); } while (0)
#define GMLP(i_, j_, xin_) do { \
        { GF f = mkgf(Hb, D, D, gm_w_in + (size_t)(j_) * D * 4096, 4096, EP_GELU, Z, 4096); ph_gemm(C, f, 4096 / 64, 1); } GRID_BAR(); \
        ph_vln(C, Z, gm_ln_g + (size_t)(j_) * GW, gm_ln_b + (size_t)(j_) * GW, VLN); GRID_BAR(); \
        ph_mix(C, Z, VLN, gm_w_s + (size_t)(j_) * GMG * CH * CH, gm_b_s + (size_t)(j_) * GMG * CH, G); GRID_BAR(); \
        { GF f = mkgf(G, GW, GW, gm_w_out + (size_t)(j_) * GW * D, D, EP_F32, Y, D); ph_gemm(C, f, D / 64, 1); } GRID_BAR(); \
        LN_PHASE(i_, 0, xin_, false); } while (0)
#define FFN(i_, fi_, last_) do { \
        { GF f = mkgf(Hb, D, D, ffn_w13 + (size_t)(fi_) * D * 2 * F, 2 * F, EP_SWIGLU, ACT, F); ph_gemm(C, f, F / 32, 1); } GRID_BAR(); \
        { GF f = mkgf(ACT, F, F, ffn_w2 + (size_t)(fi_) * F * D, D, EP_F32, Y, D); ph_gemm(C, f, D / 64, 1); } GRID_BAR(); \
        LN_PHASE(i_, 1, X, last_); } while (0)
#define MOE(i_, mi_, last_) do { int* cnt = ctl + CW_CNT + 16 * (mi_); \
        ph_route(C, X, MOD + (size_t)(i_) * 2 * 6 * D, moe_wr + (size_t)(mi_) * D * NE, moe_br + (size_t)(mi_) * NE, cnt, tok_e, tok_g, tok_pos, list); GRID_BAR(); \
        { GF f = mkgf(Hb, D, D, moe_w13 + (size_t)(mi_) * NE * D * 2 * F, 2 * F, EP_SWIGLU, ACT, F); f.gather = list; f.cnt = cnt; f.bz = (size_t)D * 2 * F; ph_gemm(C, f, F / 32, NE); } GRID_BAR(); \
        { GF f = mkgf(ACT, F, F, moe_w2 + (size_t)(mi_) * NE * F * D, D, EP_BF16, YS, D); f.cnt = cnt; f.a_compact = 1; f.bz = (size_t)F * D; ph_gemm(C, f, D / 64, NE); } GRID_BAR(); \
        { LnArgs a; a.xin = X; a.y = nullptr; a.xout = (last_) ? args.out : X; a.hout = (last_) ? nullptr : Hb; \
          a.gate = MOD + (size_t)(i_) * 2 * 6 * D + 5 * D; a.gamma = ln_g + (size_t)((i_) * 2 + 1) * D; a.beta = ln_b + (size_t)((i_) * 2 + 1) * D; a.nsh = MOD + (size_t)((i_) + 1) * 2 * 6 * D; \
          a.ys = YS; a.tok_e = tok_e; a.tok_pos = tok_pos; a.tok_g = tok_g; a.cnt = cnt; ph_ln(C, a); } if (!(last_)) GRID_BAR(); } while (0)

    GMLP(0, 0, x);
    FFN(0, 0, false);
    { GF f = mkgf(Hb, D, D, fox_w_in, 3 * D + H, EP_QKV, Qb, D); ph_gemm(C, f, 3 * D / 64, 1); }
    ph_flogit(C, X, MOD + (size_t)1 * 2 * 6 * D, fox_w_in, fox_b_f, LF); GRID_BAR();
    ph_fscan(C, LF, CUM); GRID_BAR();
    ph_attn(C, Qb, Kb, Vb, CUM, AO); GRID_BAR();
    { GF f = mkgf(AO, D, D, fox_w_out, D, EP_F32, Y, D); ph_gemm(C, f, D / 64, 1); } GRID_BAR();
    LN_PHASE(1, 0, X, false);
    MOE(1, 0, false);
    { GF f = mkgf(Hb, D, D, pool_w_in, D, EP_BF16, PZ, D); ph_gemm(C, f, D / 64, 1); } GRID_BAR();
    ph_pool(C, PZ, PP); GRID_BAR();
    { GF f = mkgf(PP, D, 256, pool_w_grp, 256, EP_BF16, PG, D); f.colscale = pool_scale; f.grouped = 1; ph_gemm(C, f, D / 64, 1); } GRID_BAR();
    { GF f = mkgf(PG, D, D, pool_w_out, D, EP_F32, Y, D); ph_gemm(C, f, D / 64, 1); } GRID_BAR();
    LN_PHASE(2, 0, X, false);
    FFN(2, 1, false);
    GMLP(3, 1, X);
    MOE(3, 1, true);
}

extern "C" void kernel_launch(void* const* d_in, const int* in_sizes, int n_in, void* d_out, int out_size, void* d_ws, size_t ws_size, hipStream_t stream) {
    static int grid = 0;
    if (grid == 0) {
        if (n_in != 25 || ws_size < WS_END || out_size != M * D) { fprintf(stderr, "kernel_launch: unexpected shapes (n_in %d, ws %zu, out %d)\n", n_in, ws_size, out_size); grid = -1; return; }
        int dev = 0, cus = 0, per_cu = 0;
        if (hipGetDevice(&dev) != hipSuccess || hipDeviceGetAttribute(&cus, hipDeviceAttributeMultiprocessorCount, dev) != hipSuccess) { grid = -1; return; }
        if (hipFuncSetAttribute((const void*)mega_fwd, hipFuncAttributeMaxDynamicSharedMemorySize, LDS_BYTES) != hipSuccess) { fprintf(stderr, "kernel_launch: hipFuncSetAttribute failed\n"); grid = -1; return; }
        if (hipOccupancyMaxActiveBlocksPerMultiprocessor(&per_cu, (const void*)mega_fwd, NWAVES * 64, LDS_BYTES) != hipSuccess || per_cu < 1) { fprintf(stderr, "kernel_launch: occupancy query says %d\n", per_cu); }
        (void)hipGetLastError();
        grid = cus;
    }
    if (grid < 0) return;
    if (hipMemsetAsync((char*)d_ws + WS_CTL, 0, CTL_ZERO_BYTES, stream) != hipSuccess) return;
    Args a; memset(&a, 0, sizeof a);
    for (int i = 0; i < 25; ++i) a.in[i] = (const float*)d_in[i];
    a.out = (float*)d_out; a.ws = (unsigned char*)d_ws;
    hipLaunchKernelGGL(mega_fwd, dim3(grid), dim3(NWAVES * 64), LDS_BYTES, stream, a);
}
```

```cpp
#include <hip/hip_runtime.h>
#include <hip/hip_bf16.h>
#include <cmath>
#include <cstdio>
#include <cstdint>
#include <cstring>

typedef unsigned short bf16;
typedef short bf16x8 __attribute__((ext_vector_type(8)));
typedef float f32x4 __attribute__((ext_vector_type(4)));
typedef unsigned u32x4 __attribute__((ext_vector_type(4)));
typedef unsigned u32x2 __attribute__((ext_vector_type(2)));

constexpr int D = 1024, NB = 2, S = 8192, M = NB * S, DEPTH = 4;
constexpr int GW = 2048, GMG = 8, CH = 128, F = 3584, NE = 8, H = 16, HD = 64;
constexpr float LN_EPS = 1e-5f;
constexpr float DN_ALPHA = 1.6817928305074290860622509524664f;
constexpr float LOG2E = 1.4426950408889634f;
constexpr float QSCALE = 0.125f * LOG2E;

constexpr size_t MiB = 1u << 20;
constexpr size_t WS_CTL = 0;
constexpr size_t WS_MOD = 1 * MiB;
constexpr size_t WS_X = 2 * MiB;
constexpr size_t WS_Y = 66 * MiB;
constexpr size_t WS_H = 130 * MiB;
constexpr size_t WS_Z = 162 * MiB;
constexpr size_t WS_VLN = 290 * MiB;
constexpr size_t WS_G = 354 * MiB;
constexpr size_t WS_ACT = 418 * MiB;
constexpr size_t WS_Q = 658 * MiB;
constexpr size_t WS_AO = 754 * MiB;
constexpr size_t WS_LF = 786 * MiB;
constexpr size_t WS_CUM = 787 * MiB;
constexpr size_t WS_PZ = 788 * MiB;
constexpr size_t WS_PP = 820 * MiB;
constexpr size_t WS_PG = 852 * MiB;
constexpr size_t WS_YS = 884 * MiB;
constexpr size_t WS_RT = 952 * MiB;
constexpr size_t WS_VST = 956 * MiB;
constexpr size_t WS_WT = 960 * MiB;
constexpr size_t WT_GM_IN = WS_WT, WT_GM_OUT = WS_WT + 16 * MiB, WT_FOX_IN = WS_WT + 24 * MiB, WT_FOX_OUT = WS_WT + 30 * MiB, WT_POOL_IN = WS_WT + 32 * MiB, WT_POOL_OUT = WS_WT + 34 * MiB,
                 WT_POOL_GRP = WS_WT + 36 * MiB, WT_FFN13 = WS_WT + 37 * MiB, WT_FFN2 = WS_WT + 65 * MiB, WT_MOE13 = WS_WT + 79 * MiB, WT_MOE2 = WS_WT + 303 * MiB;
constexpr size_t WS_XS = 1376 * MiB;
constexpr size_t WS_END = 1632 * MiB;
constexpr int CW_CNT = 64;

__device__ __forceinline__ unsigned f2bf(float f) { unsigned u = __builtin_bit_cast(unsigned, f); return (u + 0x7fffu + ((u >> 16) & 1u)) >> 16; }
__device__ __forceinline__ float bf2f(unsigned short u) { return __builtin_bit_cast(float, (unsigned)u << 16); }
__device__ __forceinline__ unsigned pk2(float lo, float hi) { return f2bf(lo) | (f2bf(hi) << 16); }
__device__ __forceinline__ float wave_sum(float v) {
#pragma unroll
    for (int o = 1; o < 64; o <<= 1) v += __shfl_xor(v, o);
    return v;
}
__device__ __forceinline__ float wave_max(float v) {
#pragma unroll
    for (int o = 1; o < 64; o <<= 1) v = fmaxf(v, __shfl_xor(v, o));
    return v;
}
__device__ __forceinline__ float silu_f(float v) { return v / (1.f + __expf(-v)); }
__device__ __forceinline__ float gelu_f(float v) { return 0.5f * v * (1.f + erff(v * 0.70710678118654752f)); }


namespace pg8 {
#define PG8_LAS __attribute__((address_space(3)))
typedef unsigned short bf16_t;
typedef short bf16x8 __attribute__((ext_vector_type(8)));
typedef float f32x4 __attribute__((ext_vector_type(4)));
typedef unsigned u32x4 __attribute__((ext_vector_type(4)));
constexpr int M_ROWS = 16384;
constexpr int BM = 256, BK = 64, HALF = 128, HTB = HALF * BK * 2  , STAGE_BYTES = 8 * HTB, NXCD = 8, WGM = 8;

__host__ __device__ __forceinline__ int lds_byte(int r, int c) { const int st = (r >> 4) * 2 + (c >> 5), rr = r & 15, cc = c & 31, ob = rr * 64 + cc * 2; return st * 1024 + (ob ^ (((ob >> 9) & 1) << 5)); }
__host__ __device__ __forceinline__ void stage_rc(int b, int& R, int& C) { const int st = b / 1024, sb = b % 1024, swz = sb ^ (((sb >> 9) & 1) << 5); R = (st >> 1) * 16 + swz / 64; C = (st & 1) * 32 + (swz % 64) / 2; }
__host__ __device__ __forceinline__ int perm32(int rho) { const int n = rho >> 4, i = rho & 15; return 8 * (i >> 2) + 4 * n + (i & 3); }

struct Unit { int pm, pn, pa, bt, acol; };
struct Gemm { const bf16_t* A; const bf16_t* Bt; int lda, K; };

struct StaticOrder {
    int nM, nN, nwg, G, c;
    __host__ __device__ void init(int M, int N, int G_, int c_) { nM = M / BM; nN = N / BM; nwg = nM * nN; G = G_; c = c_; }
    __host__ __device__ bool next(int i, Unit& u) const {
        const long L = (long)i * G + c; if (L >= nwg) return false;
        int wgid = (int)L; { const int q = nwg / NXCD, r = nwg % NXCD, xcd = wgid % NXCD, off = wgid / NXCD; wgid = (xcd < r ? xcd * (q + 1) : r * (q + 1) + (xcd - r) * q) + off; }
        const int nig = WGM * nN, gid = wgid / nig, fm = gid * WGM, gsz = (nM - fm) < WGM ? (nM - fm) : WGM;
        u.pm = fm + ((wgid % nig) % gsz); u.pn = (wgid % nig) / gsz; u.pa = u.pm; u.bt = u.pn; u.acol = 0; return true;
    }
    __device__ __forceinline__ void a_ready(const Unit&) const {}
    __device__ __forceinline__ void done(const Unit&) const {}
};

__device__ __forceinline__ unsigned cvt_pk_bf16(float lo, float hi) { unsigned r; asm volatile("v_cvt_pk_bf16_f32 %0, %1, %2" : "=v"(r) : "v"(lo), "v"(hi)); return r; }
typedef float f32x2 __attribute__((ext_vector_type(2)));
__device__ __forceinline__ f32x2 gelu_pk(f32x2 v) {
    const f32x2 av = __builtin_elementwise_abs(v), d = av * 0.2316418882f + 1.0f;
    f32x2 t; t.x = __builtin_amdgcn_rcpf(d.x); t.y = __builtin_amdgcn_rcpf(d.y);
    f32x2 q = t * 0.5307027145f + (-0.7265760135f); q = q * t + 0.7107068705f; q = q * t + (-0.142248368f); q = q * t + 0.127414796f; q = q * t;
    const f32x2 s = (v * v) * (-0.72134752044f);
    f32x2 e; e.x = __builtin_amdgcn_exp2f(s.x); e.y = __builtin_amdgcn_exp2f(s.y);
    const f32x2 m = v * (q * e), r = v - m;
    f32x2 o; o.x = v.x < 0.f ? m.x : r.x; o.y = v.y < 0.f ? m.y : r.y; return o;
}
__device__ __forceinline__ float silu_fast(float v) { return v * __builtin_amdgcn_rcpf(1.0f + __builtin_amdgcn_exp2f(v * -1.4426950408889634f)); }

struct EpiF32 {
    static constexpr bool PERM = false, AFTER_DRAIN = false;
    float* C; int ldc;
    __device__ __forceinline__ void operator()(const f32x4 (&acc)[2][2][4][2], const Unit& u, int wr, int wc, int fr, int fq) const {
        const int row0 = u.pm * BM + wr * 64 + fr, col0 = u.pn * BM + wc * 32 + 4 * fq;
#pragma unroll
        for (int ai = 0; ai < 2; ++ai)
#pragma unroll
            for (int m = 0; m < 4; ++m) { float* rowp = C + (size_t)(row0 + ai * HALF + m * 16) * ldc + col0;
#pragma unroll
                for (int bj = 0; bj < 2; ++bj)
#pragma unroll
                    for (int n = 0; n < 2; ++n) *(f32x4*)(rowp + bj * HALF + n * 16) = acc[ai][bj][m][n]; }
    }
};
template <int ACT> struct EpiBf16 {
    static constexpr bool PERM = true, AFTER_DRAIN = false;
    bf16_t* O; int ldc; int split_cols; size_t split_stride; float scale0; const float* colscale; float* vst; int vst_pn0;
    __device__ __forceinline__ void operator()(const f32x4 (&acc)[2][2][4][2], const Unit& u, int wr, int wc, int fr, int fq) const {
        const int row0 = u.pm * BM + wr * 64 + fr; int colt = u.pn * BM; bf16_t* base = O;
        float sc = 1.f; if (split_cols) { const int t = colt / split_cols; base += (size_t)t * split_stride; colt -= t * split_cols; if (t == 0) sc = scale0; }
        const int col0 = colt + wc * 32 + 8 * fq, ccol0 = u.pn * BM + wc * 32 + 8 * fq;
        f32x4 cs[2][2];
#pragma unroll
        for (int bj = 0; bj < 2; ++bj)
#pragma unroll
            for (int n = 0; n < 2; ++n) cs[bj][n] = colscale ? *(const f32x4*)(colscale + ccol0 + bj * HALF + 4 * n) * sc : (f32x4){sc, sc, sc, sc};
        const bool do_st = (ACT == 1) && vst != nullptr && u.pn >= vst_pn0;
#pragma unroll
        for (int ai = 0; ai < 2; ++ai)
#pragma unroll
            for (int m = 0; m < 4; ++m) { bf16_t* rowp = base + (size_t)(row0 + ai * HALF + m * 16) * ldc + col0; float s1 = 0.f, s2 = 0.f;
#pragma unroll
                for (int bj = 0; bj < 2; ++bj) { f32x4 v0 = acc[ai][bj][m][0], v1 = acc[ai][bj][m][1];
                    if (ACT == 1) { f32x2 a = gelu_pk((f32x2){v0[0], v0[1]}), b = gelu_pk((f32x2){v0[2], v0[3]}), c = gelu_pk((f32x2){v1[0], v1[1]}), d = gelu_pk((f32x2){v1[2], v1[3]});
                        v0 = (f32x4){a.x, a.y, b.x, b.y}; v1 = (f32x4){c.x, c.y, d.x, d.y};
                        s1 += ((v0[0] + v0[1]) + (v0[2] + v0[3])) + ((v1[0] + v1[1]) + (v1[2] + v1[3]));
                        s2 += ((v0[0] * v0[0] + v0[1] * v0[1]) + (v0[2] * v0[2] + v0[3] * v0[3])) + ((v1[0] * v1[0] + v1[1] * v1[1]) + (v1[2] * v1[2] + v1[3] * v1[3])); }
                    v0 = v0 * cs[bj][0]; v1 = v1 * cs[bj][1]; u32x4 w; w.x = cvt_pk_bf16(v0[0], v0[1]); w.y = cvt_pk_bf16(v0[2], v0[3]); w.z = cvt_pk_bf16(v1[0], v1[1]); w.w = cvt_pk_bf16(v1[2], v1[3]);
                    *(u32x4*)(rowp + bj * HALF) = w; }
                if (ACT == 1) { if (do_st) { s1 += __shfl_xor(s1, 16); s1 += __shfl_xor(s1, 32); s2 += __shfl_xor(s2, 16); s2 += __shfl_xor(s2, 32);
                    if (fq == 0) { f32x2 st; st.x = s1; st.y = s2; *(f32x2*)(vst + ((size_t)(row0 + ai * HALF + m * 16) * 32 + (u.pn - vst_pn0) * 4 + wc) * 2) = st; } } } }
    }
};
struct EpiSwiglu {
    static constexpr bool PERM = true, AFTER_DRAIN = false;
    bf16_t* O; int ldo;
    __device__ __forceinline__ void operator()(const f32x4 (&acc)[2][2][4][2], const Unit& u, int wr, int wc, int fr, int fq) const {
        const int row0 = u.pm * BM + wr * 64 + fr, col0 = u.pn * HALF + wc * 32 + 8 * fq;
#pragma unroll
        for (int ai = 0; ai < 2; ++ai)
#pragma unroll
            for (int m = 0; m < 4; ++m) { bf16_t* rowp = O + (size_t)(row0 + ai * HALF + m * 16) * ldo + col0;
                const f32x4 a0 = acc[ai][0][m][0], a1 = acc[ai][0][m][1], b0 = acc[ai][1][m][0], b1 = acc[ai][1][m][1];
                u32x4 w; w.x = cvt_pk_bf16(silu_fast(a0[0]) * b0[0], silu_fast(a0[1]) * b0[1]); w.y = cvt_pk_bf16(silu_fast(a0[2]) * b0[2], silu_fast(a0[3]) * b0[3]);
                w.z = cvt_pk_bf16(silu_fast(a1[0]) * b1[0], silu_fast(a1[1]) * b1[1]); w.w = cvt_pk_bf16(silu_fast(a1[2]) * b1[2], silu_fast(a1[3]) * b1[3]);
                *(u32x4*)rowp = w; }
    }
};
struct SchedPlain : StaticOrder { int btoff;
    __device__ __forceinline__ bool next(int i, Unit& u) const { if (!StaticOrder::next(i, u)) return false; u.bt += btoff; return true; } };
struct SchedPoolGrp : StaticOrder {
    __device__ __forceinline__ bool next(int i, Unit& u) const { if (!StaticOrder::next(i, u)) return false; u.acol = 256 * u.pn; return true; } };

template <class Epi, class Sched, bool ALIGN_EPI = false, bool SP2 = false>
__device__ __forceinline__ void gemm_phase(PG8_LAS unsigned char* lds, const Gemm g, const Sched& S, const Epi& E) {
    int tid_ = threadIdx.x; asm volatile("" : "+v"(tid_));
    const int tid = tid_, wid = __builtin_amdgcn_readfirstlane(tid >> 6), lane = tid & 63, wr = wid >> 2, wc = wid & 3, fr = lane & 15, fq = lane >> 4;
    const int K = g.K, nt = K / BK, lda = g.lda;
    unsigned voffA[2], voffB[2];
#pragma unroll
    for (int i = 0; i < 2; ++i) { int R, C; stage_rc(tid * 16 + i * 8192, R, C); const int Rb = Epi::PERM ? ((R & ~31) + perm32(R & 31)) : R;
        voffA[i] = (unsigned)(R * lda + C) * 2u; voffB[i] = (unsigned)(Rb * K + C) * 2u; }
    const size_t kstep = (size_t)(BK * 2);
    const size_t hstepA = (size_t)HALF * lda * 2, hstepB = (size_t)HALF * K * 2;
    const size_t tstepB = 2 * hstepB;
    const unsigned ldsw = (unsigned)wid * 1024u;
    const int aoff = lds_byte(wr * 64 + fr, fq * 8), boff = lds_byte(wc * 32 + fr, fq * 8);
#define PG8_ABASE(u) ((const char*)g.A + ((size_t)(u).pa * BM * lda + (size_t)(u).acol) * 2)
#define PG8_BBASE(u) ((const char*)g.Bt + (size_t)(u).bt * tstepB)
#define PG8_SA(b, h) (((b) * 2 + (h)) * HTB)
#define PG8_SB(b, h) ((4 + (b) * 2 + (h)) * HTB)
#define PG8_STAGE(bufoff, gbase, voff) do { _Pragma("unroll") for (int _i = 0; _i < 2; ++_i) \
        __builtin_amdgcn_global_load_lds((const unsigned*)((const char*)(gbase) + (voff)[_i]), (PG8_LAS unsigned*)(lds + (bufoff) + ldsw + _i * 8192), 16, 0, 0); } while (0)
#define PG8_LDA(dst, b, h) do { _Pragma("unroll") for (int m = 0; m < 4; ++m) _Pragma("unroll") for (int k = 0; k < 2; ++k) dst[m][k] = *(const PG8_LAS bf16x8*)(lds + PG8_SA(b, h) + aoff + m * 2048 + k * 1024); } while (0)
#define PG8_LDB(dst, b, h) do { _Pragma("unroll") for (int n = 0; n < 2; ++n) _Pragma("unroll") for (int k = 0; k < 2; ++k) dst[n][k] = *(const PG8_LAS bf16x8*)(lds + PG8_SB(b, h) + boff + n * 2048 + k * 1024); } while (0)
#define PG8_MMA(ai, bj, At, Bt) do { __builtin_amdgcn_s_setprio(1); _Pragma("unroll") for (int m = 0; m < 4; ++m) _Pragma("unroll") for (int n = 0; n < 2; ++n) _Pragma("unroll") for (int k = 0; k < 2; ++k) \
        acc[ai][bj][m][n] = __builtin_amdgcn_mfma_f32_16x16x32_bf16(Bt[n][k], At[m][k], acc[ai][bj][m][n], 0, 0, 0); __builtin_amdgcn_s_setprio(0); } while (0)
#define PG8_WAIT_V(n) asm volatile("s_waitcnt vmcnt(" #n ")" ::: "memory")
#define PG8_WAIT_L(n) asm volatile("s_waitcnt lgkmcnt(" #n ")" ::: "memory")
#define PG8_BAR __builtin_amdgcn_s_barrier()
#define PG8_SCHED __builtin_amdgcn_sched_barrier(0)
    Unit cur, nxt; int ui = 0;
    if (!S.next(0, cur)) return;
    f32x4 acc[2][2][4][2];
#pragma unroll
    for (int a = 0; a < 2; ++a)
#pragma unroll
        for (int b = 0; b < 2; ++b)
#pragma unroll
            for (int m = 0; m < 4; ++m)
#pragma unroll
                for (int n = 0; n < 2; ++n) acc[a][b][m][n] = (f32x4){0.f, 0.f, 0.f, 0.f};
    bf16x8 At[4][2], B0[2][2], B1[2][2];
    const char* cA = PG8_ABASE(cur); const char* cB = PG8_BBASE(cur);
    S.a_ready(cur);
    if constexpr (SP2) {
        PG8_STAGE(PG8_SB(0, 0), cB, voffB); PG8_STAGE(PG8_SB(0, 1), cB + hstepB, voffB); PG8_STAGE(PG8_SA(0, 0), cA, voffA); PG8_STAGE(PG8_SA(0, 1), cA + hstepA, voffA);
        if (wr == 1) PG8_BAR;
        PG8_WAIT_V(2); PG8_BAR;
        PG8_STAGE(PG8_SB(1, 0), cB + kstep, voffB); PG8_STAGE(PG8_SA(1, 0), cA + kstep, voffA); PG8_STAGE(PG8_SB(1, 1), cB + hstepB + kstep, voffB);
        PG8_WAIT_V(6); PG8_BAR;
    } else {
        PG8_STAGE(PG8_SB(0, 0), cB, voffB); PG8_STAGE(PG8_SA(0, 0), cA, voffA); PG8_STAGE(PG8_SB(0, 1), cB + hstepB, voffB); PG8_STAGE(PG8_SA(0, 1), cA + hstepA, voffA);
        if (wr == 1) PG8_BAR;
        PG8_WAIT_V(4); PG8_BAR;
        PG8_STAGE(PG8_SB(1, 0), cB + kstep, voffB); PG8_STAGE(PG8_SA(1, 0), cA + kstep, voffA); PG8_STAGE(PG8_SB(1, 1), cB + hstepB + kstep, voffB);
        PG8_WAIT_V(6); PG8_BAR;
    }
    for (;;) {
        const bool has_next = S.next(ui + 1, nxt);
        const char* nA = has_next ? PG8_ABASE(nxt) : cA; const char* nB = has_next ? PG8_BBASE(nxt) : cB;
        for (int t = 0; t < nt; t += 2) {
            const bool last = (t == nt - 2);
            const char* a1 = cA + (size_t)(t + 1) * kstep;
            const char* a2 = last ? nA : cA + (size_t)(t + 2) * kstep; const char* b2 = last ? nB : cB + (size_t)(t + 2) * kstep;
            const char* a3 = a2 + kstep; const char* b3 = b2 + kstep;
            if (last && has_next) S.a_ready(nxt);
            if constexpr (SP2) {
            PG8_LDB(B0, 0, 0); PG8_LDB(B1, 0, 1); PG8_SCHED; PG8_LDA(At, 0, 0); PG8_STAGE(PG8_SA(1, 1), a1 + hstepA, voffA);
            PG8_WAIT_V(8); PG8_WAIT_L(0); PG8_BAR; PG8_MMA(0, 0, At, B0); PG8_MMA(0, 1, At, B1); PG8_BAR; PG8_SCHED;
            PG8_LDA(At, 0, 1); PG8_STAGE(PG8_SB(0, 0), b2, voffB); PG8_STAGE(PG8_SB(0, 1), b2 + hstepB, voffB); PG8_STAGE(PG8_SA(0, 0), a2, voffA);
            PG8_WAIT_V(8); PG8_WAIT_L(0); PG8_BAR; PG8_MMA(1, 0, At, B0); PG8_MMA(1, 1, At, B1); PG8_BAR; PG8_SCHED;
            PG8_LDB(B0, 1, 0); PG8_LDB(B1, 1, 1); PG8_SCHED; PG8_LDA(At, 1, 0); PG8_STAGE(PG8_SA(0, 1), a2 + hstepA, voffA);
            PG8_WAIT_V(8); PG8_WAIT_L(0); PG8_BAR; PG8_MMA(0, 0, At, B0); PG8_MMA(0, 1, At, B1); PG8_BAR; PG8_SCHED;
            PG8_LDA(At, 1, 1); PG8_STAGE(PG8_SB(1, 0), b3, voffB); PG8_STAGE(PG8_SB(1, 1), b3 + hstepB, voffB); PG8_STAGE(PG8_SA(1, 0), a3, voffA);
            PG8_WAIT_V(8); PG8_WAIT_L(0); PG8_BAR; PG8_MMA(1, 0, At, B0); PG8_MMA(1, 1, At, B1); PG8_BAR; PG8_SCHED;
            } else {
            PG8_LDB(B0, 0, 0); PG8_SCHED; PG8_LDA(At, 0, 0); PG8_STAGE(PG8_SA(1, 1), a1 + hstepA, voffA);
            PG8_WAIT_L(8); PG8_BAR; PG8_WAIT_L(0); PG8_MMA(0, 0, At, B0); PG8_BAR; PG8_SCHED;
            PG8_LDB(B1, 0, 1); PG8_STAGE(PG8_SB(0, 0), b2, voffB);
            PG8_BAR; PG8_WAIT_L(0); PG8_MMA(0, 1, At, B1); PG8_BAR;
            PG8_LDA(At, 0, 1); PG8_STAGE(PG8_SA(0, 0), a2, voffA);
            PG8_BAR; PG8_WAIT_L(0); PG8_MMA(1, 0, At, B0); PG8_BAR; PG8_SCHED;
            PG8_STAGE(PG8_SB(0, 1), b2 + hstepB, voffB);
            PG8_WAIT_V(6); PG8_BAR; PG8_MMA(1, 1, At, B1); PG8_BAR;
            PG8_LDB(B0, 1, 0); PG8_SCHED; PG8_LDA(At, 1, 0); PG8_STAGE(PG8_SA(0, 1), a2 + hstepA, voffA);
            PG8_WAIT_L(8); PG8_BAR; PG8_WAIT_L(0); PG8_MMA(0, 0, At, B0); PG8_BAR; PG8_SCHED;
            PG8_LDB(B1, 1, 1); PG8_STAGE(PG8_SB(1, 0), b3, voffB);
            PG8_BAR; PG8_WAIT_L(0); PG8_MMA(0, 1, At, B1); PG8_BAR;
            PG8_LDA(At, 1, 1); PG8_STAGE(PG8_SA(1, 0), a3, voffA);
            PG8_BAR; PG8_WAIT_L(0); PG8_MMA(1, 0, At, B0); PG8_BAR; PG8_SCHED;
            PG8_STAGE(PG8_SB(1, 1), b3 + hstepB, voffB);
            PG8_WAIT_V(6); PG8_BAR; PG8_MMA(1, 1, At, B1); PG8_BAR;
            }
        }
        if constexpr (ALIGN_EPI) { if (wr == 0) PG8_BAR; }
        if constexpr (!Epi::AFTER_DRAIN) { E(acc, cur, wr, wc, fr, fq); S.done(cur); }
        if (!has_next) break;
#pragma unroll
        for (int a = 0; a < 2; ++a)
#pragma unroll
            for (int b = 0; b < 2; ++b)
#pragma unroll
                for (int m = 0; m < 4; ++m)
#pragma unroll
                    for (int n = 0; n < 2; ++n) acc[a][b][m][n] = (f32x4){0.f, 0.f, 0.f, 0.f};
        cur = nxt; cA = nA; cB = nB; ++ui;
        if constexpr (ALIGN_EPI) { if (wr == 1) PG8_BAR; }
    }
    PG8_WAIT_V(0);
    if constexpr (!ALIGN_EPI) { if (wr == 0) PG8_BAR; }
    PG8_BAR;
    if constexpr (Epi::AFTER_DRAIN) { E.fused(acc, cur, wr, wc, fr, fq, lds, wid, lane); S.done(cur); }
#undef PG8_SA
#undef PG8_ABASE
#undef PG8_BBASE
#undef PG8_SB
#undef PG8_STAGE
#undef PG8_LDA
#undef PG8_LDB
#undef PG8_MMA
#undef PG8_WAIT_V
#undef PG8_WAIT_L
#undef PG8_BAR
#undef PG8_SCHED
}
template <bool A_FIXED> struct SchedMoE : StaticOrder {
    int tb1, tb2, tb3, tb4, tb5, tb6, tb7, nn;
    __device__ __forceinline__ void setup(const int* cnt, int N, int G_, int c_) {
        const int t0 = (cnt[0] + 255) >> 8, t1 = (cnt[1] + 255) >> 8, t2 = (cnt[2] + 255) >> 8, t3 = (cnt[3] + 255) >> 8, t4 = (cnt[4] + 255) >> 8, t5 = (cnt[5] + 255) >> 8, t6 = (cnt[6] + 255) >> 8, t7 = (cnt[7] + 255) >> 8;
        tb1 = t0; tb2 = tb1 + t1; tb3 = tb2 + t2; tb4 = tb3 + t3; tb5 = tb4 + t4; tb6 = tb5 + t5; tb7 = tb6 + t6; nn = N / BM;
        init((tb7 + t7) * BM, N, G_, c_);
    }
    __device__ __forceinline__ bool next(int i, Unit& u) const {
        if (!StaticOrder::next(i, u)) return false;
        const int pm = u.pm;
        const int e = (pm >= tb1) + (pm >= tb2) + (pm >= tb3) + (pm >= tb4) + (pm >= tb5) + (pm >= tb6) + (pm >= tb7);
        const int tb = (e == 0) ? 0 : (e == 1) ? tb1 : (e == 2) ? tb2 : (e == 3) ? tb3 : (e == 4) ? tb4 : (e == 5) ? tb5 : (e == 6) ? tb6 : tb7;
        u.bt = e * nn + u.pn; u.pa = A_FIXED ? e * (M_ROWS / BM) + (pm - tb) : pm; return true;
    }
};
}

namespace attn_body {
using bf16=__hip_bfloat16;
using bf16x8=__attribute__((ext_vector_type(8)))short;
using s16x4=__attribute__((ext_vector_type(4)))short;
using f32x16=__attribute__((ext_vector_type(16)))float;
using u32x4=__attribute__((ext_vector_type(4)))unsigned;
using f32x4_t=__attribute__((ext_vector_type(4)))float;
constexpr int BATCH=2,NHEAD=16,SEQ=8192,D=64,DM=NHEAD*D;
constexpr int NW=8,QBLK=32,QB=QBLK*NW,KVBLK=64,NQB=SEQ/QB;
constexpr int ATTN_PITCH=DM, ATTN_UNIT_ROWS=QB;
__device__ __forceinline__ int crow(int r,int hi){return (r&3)+8*(r>>2)+4*hi;}
#define SBAR() __builtin_amdgcn_sched_barrier(0)
__device__ __forceinline__ void cmask(f32x16&p0,f32x16&p1,int jb,int qrel,int hi){
  const float NEG=-INFINITY; int kb=64*jb+4*hi;
  #pragma unroll
  for(int r=0;r<16;++r){int kv=kb+(r&3)+8*(r>>2); if(kv>qrel)p0[r]=NEG; if(kv+32>qrel)p1[r]=NEG;}
}

constexpr int NSLOT=3, SLOTB=8192;
constexpr int LDS_K=0, LDS_V=NSLOT*SLOTB, LDS_WS=2*NSLOT*SLOTB, LDS_OST=LDS_WS+NW*64*4, LDS_NCK=LDS_OST+NW*4096, LDS_BYTES=LDS_NCK+SEQ*4;
constexpr float C2=0.125f*1.4426950408889634f;
__device__ __forceinline__ void glds16(const void*gsrc,unsigned lds_dst){unsigned keep;
  asm volatile("s_mov_b32 %0, m0\n\ts_mov_b32 m0, %2\n\ts_nop 0\n\tglobal_load_lds_dwordx4 %1, off\n\ts_mov_b32 m0, %0":"=&s"(keep):"v"(gsrc),"s"(lds_dst):"memory");}
__device__ __forceinline__ float max3f(float a,float b,float c){float r;asm("v_max3_f32 %0, %1, %2, %3":"=v"(r):"v"(a),"v"(b),"v"(c));return r;}
__device__ __forceinline__ float max2f(float a,float b){float r;asm("v_max_f32_e32 %0, %1, %2":"=v"(r):"v"(a),"v"(b));return r;}
__device__ __forceinline__ float fadd_s(float a,float b){float r;asm("v_add_f32_e32 %0, %1, %2":"=v"(r):"v"(a),"v"(b));return r;}
__device__ __forceinline__ float fsub_s(float a,float b){float r;asm("v_sub_f32_e32 %0, %1, %2":"=v"(r):"v"(a),"v"(b));return r;}
typedef float f32x2_t __attribute__((ext_vector_type(2))); typedef __bf16 bf16x2_t __attribute__((ext_vector_type(2)));
__device__ __forceinline__ unsigned cvtpk_s(float lo,float hi){f32x2_t v={lo,hi};bf16x2_t b=__builtin_convertvector(v,bf16x2_t);return __builtin_bit_cast(unsigned,b);}
#define WAIT_BAR(N) asm volatile("s_waitcnt vmcnt(" #N ") lgkmcnt(0)\n\ts_barrier":::"memory")

__device__ __forceinline__ void qkt(f32x16&p0,f32x16&p1,const char*Kslot,const bf16x8*qr,int r32,int hi){
  const char*kb=Kslot+hi*1024+r32*16;
  #pragma unroll
  for(int d0=0;d0<4;++d0){
    const bf16x8 b0=*reinterpret_cast<const bf16x8*>(kb+d0*2048);
    const bf16x8 b1=*reinterpret_cast<const bf16x8*>(kb+d0*2048+512);
    p0=__builtin_amdgcn_mfma_f32_32x32x16_bf16(b0,qr[d0],p0,0,0,0);p1=__builtin_amdgcn_mfma_f32_32x32x16_bf16(b1,qr[d0],p1,0,0,0);}
}
typedef __attribute__((address_space(3))) const char* lds_cptr;
typedef short v4i16_t __attribute__((ext_vector_type(4)));
__device__ __forceinline__ void kload8(bf16x8*kf,lds_cptr kp){
  kf[0]=*(const __attribute__((address_space(3))) bf16x8*)(kp);      kf[1]=*(const __attribute__((address_space(3))) bf16x8*)(kp+512);
  kf[2]=*(const __attribute__((address_space(3))) bf16x8*)(kp+2048); kf[3]=*(const __attribute__((address_space(3))) bf16x8*)(kp+2560);
  kf[4]=*(const __attribute__((address_space(3))) bf16x8*)(kp+4096); kf[5]=*(const __attribute__((address_space(3))) bf16x8*)(kp+4608);
  kf[6]=*(const __attribute__((address_space(3))) bf16x8*)(kp+6144); kf[7]=*(const __attribute__((address_space(3))) bf16x8*)(kp+6656);
}
__device__ __forceinline__ void kload2(bf16x8*kf,lds_cptr kp,int j){ kf[2*j]=*(const __attribute__((address_space(3))) bf16x8*)(kp+j*2048); kf[2*j+1]=*(const __attribute__((address_space(3))) bf16x8*)(kp+j*2048+512); }
__device__ __forceinline__ s16x4 vtr(lds_cptr p){ return __builtin_bit_cast(s16x4,__builtin_amdgcn_ds_read_tr16_b64_v4i16((__attribute__((address_space(3))) v4i16_t*)p)); }
__device__ __forceinline__ float rowmax(const f32x16&p0,const f32x16&p1){
  float a=max3f(p0[0],p0[1],p1[0]),b=max3f(p0[2],p0[3],p1[1]);a=max3f(a,p1[2],p1[3]);
  #pragma unroll
  for(int r=4;r<16;r+=4){a=max3f(a,p0[r],p0[r+1]);b=max3f(b,p0[r+2],p0[r+3]);a=max3f(a,p1[r],p1[r+1]);b=max3f(b,p1[r+2],p1[r+3]);}
  const float m=max2f(a,b);
  auto rr=__builtin_amdgcn_permlane32_swap(__float_as_uint(m),__float_as_uint(m),false,false);
  return max2f(__uint_as_float(rr[0]),__uint_as_float(rr[1]));
}
__device__ __forceinline__ void pv(f32x16*o,int vb,bf16x8 pa0,bf16x8 pa1,bf16x8 pa2,bf16x8 pa3){
  #pragma unroll
  for(int d0=0;d0<2;++d0){s16x4 lo[4],hi[4];
    #pragma unroll
    for(int ks=0;ks<4;++ks){
      asm volatile("ds_read_b64_tr_b16 %0,%1 offset:%c2":"=&v"(lo[ks]):"v"(vb),"i"(d0*4096+ks*1024):"memory");
      asm volatile("ds_read_b64_tr_b16 %0,%1 offset:%c2":"=&v"(hi[ks]):"v"(vb),"i"(d0*4096+ks*1024+512):"memory");}
    asm volatile("s_waitcnt lgkmcnt(0)":::"memory");SBAR();
    #define PK(k) (bf16x8){lo[k][0],lo[k][1],lo[k][2],lo[k][3],hi[k][0],hi[k][1],hi[k][2],hi[k][3]}
    o[d0]=__builtin_amdgcn_mfma_f32_32x32x16_bf16(pa0,PK(0),o[d0],0,0,0);
    o[d0]=__builtin_amdgcn_mfma_f32_32x32x16_bf16(pa1,PK(1),o[d0],0,0,0);
    o[d0]=__builtin_amdgcn_mfma_f32_32x32x16_bf16(pa2,PK(2),o[d0],0,0,0);
    o[d0]=__builtin_amdgcn_mfma_f32_32x32x16_bf16(pa3,PK(3),o[d0],0,0,0);
    #undef PK
  }
}

#ifndef ATTN_STORE16
#define ATTN_STORE16(p,v) (*(u32x4*)(p)=(v))
#endif
template<int THRL> __device__ __forceinline__ void attn_unit(int b,int h,int qb,const bf16*Q,const bf16*__restrict__ K,const bf16*__restrict__ V,bf16*O,const float*__restrict__ NCK,char*shm){
  const int tid=threadIdx.x,lane=tid&63,r32=lane&31,hi=lane>>5; const int wid=__builtin_amdgcn_readfirstlane(tid>>6);
  const long rowbase=(long)b*SEQ; const int q0=qb*QB;
  const bf16*Qw=Q+(rowbase+q0+wid*QBLK)*DM+h*D;
  const bf16*Kh=K+rowbase*DM+h*D,*Vh=V+rowbase*DM+h*D;
  const unsigned lds0=(unsigned)(uintptr_t)shm;
  float*wsf=(float*)(shm+LDS_WS)+wid*64;
  const bf16*ksrc=Kh+(long)lane*DM+wid*8;
  const bf16*vsrc=Vh+(long)(16*(wid&3)+(lane>>2))*DM+(wid>>2)*32+(lane&3)*8;
  const unsigned kdst=lds0+LDS_K+wid*1024, vdst=lds0+LDS_V+wid*1024;
  #define DMA_K(t,slot) glds16(ksrc+(long)(t)*KVBLK*DM,(unsigned)__builtin_amdgcn_readfirstlane(kdst+(slot)))
  #define DMA_V(t,slot) glds16(vsrc+(long)(t)*KVBLK*DM,(unsigned)__builtin_amdgcn_readfirstlane(vdst+(slot)))
  const int vb0=(int)(lds0+LDS_V)+((lane>>4)&1)*32+(lane&3)*8+(4*hi+((lane&15)>>2))*64;
  const char*Kbase=shm+LDS_K; bf16x8 kf[8];
  const lds_cptr shm3=(lds_cptr)shm; const lds_cptr kp0=shm3+LDS_K+hi*1024+r32*16; const lds_cptr vp0=shm3+LDS_V+((lane>>4)&1)*32+(lane&3)*8+(4*hi+((lane&15)>>2))*64;
  const int NT=(q0+QB)/KVBLK;
  { const float*nsrc=NCK+(long)(b*NHEAD+h)*SEQ+lane*4;
    #pragma unroll
    for(int i=0;i<4;++i) glds16(nsrc+(i*8+wid)*256,(unsigned)__builtin_amdgcn_readfirstlane(lds0+LDS_NCK+(i*8+wid)*1024)); }
  DMA_K(0,0);DMA_V(0,0);DMA_K(1,SLOTB);
  bf16x8 qr[4];
  #pragma unroll
  for(int d0=0;d0<4;++d0)qr[d0]=*reinterpret_cast<const bf16x8*>(&Qw[(long)r32*DM+d0*16+hi*8]);
  float mhat=0.f,l_reg=0.f,cq2=0.f,base=0.f;f32x16 o[2];o[0]=f32x16{};o[1]=f32x16{};
  const int qrel=wid*QBLK+r32;
  #define CMASK(P0,P1,t) do{int jb_=(t)-(NT-4); if(jb_>=0)cmask(P0,P1,jb_,qrel,hi);}while(0)
  bool resc=false;
  #define START(P0,P1) do{ const float rm=rowmax(P0,P1); resc=false; \
    { const float dl=rm; mhat=fadd_s(mhat,dl); \
      _Pragma("unroll") for(int r=0;r<16;++r){P0[r]=fsub_s(P0[r],dl);P1[r]=fsub_s(P1[r],dl);} \
      base=cq2-mhat; } \
    _Pragma("unroll") for(int r=0;r<16;++r)P0[r]=__builtin_amdgcn_exp2f(P0[r]); }while(0)
  #define RESC() do{ if(resc){ asm volatile("s_waitcnt lgkmcnt(0)":::"memory"); \
      _Pragma("unroll") for(int d_=0;d_<2;++d_) _Pragma("unroll") for(int r=0;r<16;++r)o[d_][r]*=wsf[crow(r,hi)]; } }while(0)
  f32x16 pA0,pA1,pB0,pB1;
  int sl_prev=0,sl_cur=0,sl_next=SLOTB;
  #define ROT() do{sl_prev=sl_cur;sl_cur=sl_next;sl_next=(sl_next==(NSLOT-1)*SLOTB)?0:sl_next+SLOTB;}while(0)
  DMA_K(2,2*SLOTB);
  WAIT_BAR(3);
  const lds_cptr nckp=(lds_cptr)shm+LDS_NCK+hi*16;
  #define CINIT(C0,C1,t) do{ const lds_cptr np_=nckp+(t)*256; \
    _Pragma("unroll") for(int g_=0;g_<4;++g_){ const f32x4_t a_=*(const __attribute__((address_space(3))) f32x4_t*)(np_+g_*32); const f32x4_t b_=*(const __attribute__((address_space(3))) f32x4_t*)(np_+g_*32+128); \
      C0[4*g_]=a_[0]+base;C0[4*g_+1]=a_[1]+base;C0[4*g_+2]=a_[2]+base;C0[4*g_+3]=a_[3]+base; C1[4*g_]=b_[0]+base;C1[4*g_+1]=b_[1]+base;C1[4*g_+2]=b_[2]+base;C1[4*g_+3]=b_[3]+base; } }while(0)
  cq2=-*(const __attribute__((address_space(3))) float*)((lds_cptr)shm+LDS_NCK+(q0+wid*QBLK+r32)*4); base=cq2;
  CINIT(pA0,pA1,0);
  qkt(pA0,pA1,Kbase,qr,r32,hi);asm volatile("s_nop 15\n\ts_nop 7":"+v"(pA0),"+v"(pA1));CMASK(pA0,pA1,0);
  START(pA0,pA1);
  _Pragma("unroll") for(int r=0;r<16;++r)pA1[r]=__builtin_amdgcn_exp2f(pA1[r]);
  WAIT_BAR(0);
  DMA_K(3,0);DMA_V(1,SLOTB);
  ROT();
  kload8(kf,kp0+sl_cur);
  WAIT_BAR(2);
  s16x4 vlo[8],vhi[8]; u32x4 pw0,pw1,pw2,pw3;
  #define PKW(P,B) cvtpk_s(P[B],P[B+1])
  #define PAF(k) __builtin_bit_cast(bf16x8,pw##k)
  #define VFR(i) (bf16x8){vlo[i][0],vlo[i][1],vlo[i][2],vlo[i][3],vhi[i][0],vhi[i][1],vhi[i][2],vhi[i][3]}
  #define PIN(x) asm volatile("":"+v"(x))
  #define MX3(a,b,c) __builtin_fmaxf(__builtin_fmaxf((a),(b)),(c))
  #define GAPA(MF,A0,A1,A2,A3,W0,W1,PW) do{ MF; sacc+=A0; sacc+=A1; sacc+=A2; sacc+=A3; PIN(sacc); W0; W1; PIN(PW); SBAR(); }while(0)
  #define EX(v) __builtin_amdgcn_exp2f(v)
  #define GAPB(MF,X,B) do{ MF; X[B]=EX(X[B]); X[B+1]=EX(X[B+1]); X[B+2]=EX(X[B+2]); X[B+3]=EX(X[B+3]); PIN(X); SBAR(); }while(0)
  #define VRD(i) do{ vlo[i]=vtr(vp_+(((i)>>2)*4096+((i)&3)*1024)); vhi[i]=vtr(vp_+(((i)>>2)*4096+((i)&3)*1024+512)); }while(0)
  #define KRD(G,j) do{ if(G){ kload2(kf,kp0+sl_next,j); SBAR(); } }while(0)
  #define STEP(C0,C1,P0,P1,t,GK,GV,GL) do{ CINIT(C0,C1,t); SBAR(); \
    const lds_cptr vp_=vp0+sl_prev; \
    VRD(0); SBAR(); float sacc=(P0[0]+P0[1]); \
    GAPA(C0=__builtin_amdgcn_mfma_f32_32x32x16_bf16(kf[0],qr[0],C0,0,0,0), P0[2],P0[3],P0[4],P0[5],     pw0[0]=PKW(P0,0), pw0[1]=PKW(P0,2), pw0); \
    VRD(4); SBAR(); GAPA(C1=__builtin_amdgcn_mfma_f32_32x32x16_bf16(kf[1],qr[0],C1,0,0,0), P0[6],P0[7],P0[8],P0[9],     pw0[2]=PKW(P0,4), pw0[3]=PKW(P0,6), pw0); \
    VRD(1); SBAR(); GAPA(C0=__builtin_amdgcn_mfma_f32_32x32x16_bf16(kf[2],qr[1],C0,0,0,0),   P0[10],P0[11],P0[12],P0[13], pw1[0]=PKW(P0,8), pw1[1]=PKW(P0,10), pw1); \
    VRD(5); SBAR(); GAPA(C1=__builtin_amdgcn_mfma_f32_32x32x16_bf16(kf[3],qr[1],C1,0,0,0),   P0[14],P0[15],P1[0],P1[1],   pw1[2]=PKW(P0,12),pw1[3]=PKW(P0,14), pw1); \
    VRD(2); SBAR(); GAPA(C0=__builtin_amdgcn_mfma_f32_32x32x16_bf16(kf[4],qr[2],C0,0,0,0),   P1[2],P1[3],P1[4],P1[5],     pw2[0]=PKW(P1,0), pw2[1]=PKW(P1,2), pw2); \
    VRD(6); SBAR(); GAPA(C1=__builtin_amdgcn_mfma_f32_32x32x16_bf16(kf[5],qr[2],C1,0,0,0),   P1[6],P1[7],P1[8],P1[9],     pw2[2]=PKW(P1,4), pw2[3]=PKW(P1,6), pw2); \
    VRD(3); SBAR(); GAPA(C0=__builtin_amdgcn_mfma_f32_32x32x16_bf16(kf[6],qr[3],C0,0,0,0),   P1[10],P1[11],P1[12],P1[13], pw3[0]=PKW(P1,8), pw3[1]=PKW(P1,10), pw3); \
    VRD(7); SBAR(); GAPA(C1=__builtin_amdgcn_mfma_f32_32x32x16_bf16(kf[7],qr[3],C1,0,0,0),   P1[14],P1[15],0.f,0.f,       pw3[2]=PKW(P1,12),pw3[3]=PKW(P1,14), pw3); \
    l_reg+=sacc; \
    if(GK){DMA_K((t)+3,sl_cur);} if(GV){DMA_V((t)+1,sl_next);} \
    CMASK(C0,C1,t); \
    { float a=MX3(C0[0],C0[1],C1[0]),b=MX3(C0[2],C0[3],C1[1]); a=MX3(a,C1[2],C1[3]); \
      _Pragma("unroll") for(int r=4;r<16;r+=4){a=MX3(a,C0[r],C0[r+1]);b=MX3(b,C0[r+2],C0[r+3]);a=MX3(a,C1[r],C1[r+1]);b=MX3(b,C1[r+2],C1[r+3]);} \
      float rm=__builtin_fmaxf(a,b); { auto rr=__builtin_amdgcn_permlane32_swap(__float_as_uint(rm),__float_as_uint(rm),false,false); rm=__builtin_fmaxf(__uint_as_float(rr[0]),__uint_as_float(rr[1])); } \
      resc=false; \
      if(__builtin_expect(__any(rm>(float)THRL),0)){ const float dl=__builtin_fmaxf(rm,0.f); mhat+=dl; \
        _Pragma("unroll") for(int r=0;r<16;++r){C0[r]-=dl;C1[r]-=dl;} \
        base=cq2-mhat; \
        const float f=__builtin_amdgcn_exp2f(-dl); l_reg*=f; if(hi==0)wsf[r32]=f; resc=true; } } \
    SBAR(); \
    GAPB(o[0]=__builtin_amdgcn_mfma_f32_32x32x16_bf16(PAF(0),VFR(0),o[0],0,0,0), C0,0); \
    GAPB(o[1]=__builtin_amdgcn_mfma_f32_32x32x16_bf16(PAF(0),VFR(4),o[1],0,0,0), C0,4); \
    KRD(GL,0); GAPB(o[0]=__builtin_amdgcn_mfma_f32_32x32x16_bf16(PAF(1),VFR(1),o[0],0,0,0), C0,8); \
    KRD(GL,1); GAPB(o[1]=__builtin_amdgcn_mfma_f32_32x32x16_bf16(PAF(1),VFR(5),o[1],0,0,0), C0,12); \
    KRD(GL,2); GAPB(o[0]=__builtin_amdgcn_mfma_f32_32x32x16_bf16(PAF(2),VFR(2),o[0],0,0,0), C1,0); \
    KRD(GL,3); GAPB(o[1]=__builtin_amdgcn_mfma_f32_32x32x16_bf16(PAF(2),VFR(6),o[1],0,0,0), C1,4); \
    GAPB(o[0]=__builtin_amdgcn_mfma_f32_32x32x16_bf16(PAF(3),VFR(3),o[0],0,0,0), C1,8); \
    GAPB(o[1]=__builtin_amdgcn_mfma_f32_32x32x16_bf16(PAF(3),VFR(7),o[1],0,0,0), C1,12); \
    }while(0)
  int t=1;
  #undef CMASK
  #define CMASK(P0,P1,t) do{}while(0)
  for(;t+5<NT;t+=2){
    STEP(pB0,pB1,pA0,pA1,t,true,true,true);     WAIT_BAR(2); RESC(); ROT();
    STEP(pA0,pA1,pB0,pB1,t+1,true,true,true);   WAIT_BAR(2); RESC(); ROT();
  }
  #undef CMASK
  #define CMASK(P0,P1,t) do{int jb_=(t)-(NT-4); if(jb_>=0)cmask(P0,P1,jb_,qrel,hi);}while(0)
  #define ENDW(tt) do{ if((tt)+3<NT){WAIT_BAR(2);} else if((tt)+2<NT){WAIT_BAR(1);} else {WAIT_BAR(0);} }while(0)
  for(;t+1<NT;t+=2){
    STEP(pB0,pB1,pA0,pA1,t,(t+3<NT),(t+1<NT),(t+1<NT));       ENDW(t);   RESC(); ROT();
    STEP(pA0,pA1,pB0,pB1,t+1,(t+4<NT),(t+2<NT),(t+2<NT));     ENDW(t+1); RESC(); ROT();
  }
  STEP(pB0,pB1,pA0,pA1,NT-1,false,false,false); RESC();
  { float sacc=pB0[0]+pB0[1]; _Pragma("unroll") for(int r=2;r<16;++r)sacc+=pB0[r]; _Pragma("unroll") for(int r=0;r<16;++r)sacc+=pB1[r]; l_reg+=sacc;
    pw0=(u32x4){PKW(pB0,0),PKW(pB0,2),PKW(pB0,4),PKW(pB0,6)};pw1=(u32x4){PKW(pB0,8),PKW(pB0,10),PKW(pB0,12),PKW(pB0,14)};pw2=(u32x4){PKW(pB1,0),PKW(pB1,2),PKW(pB1,4),PKW(pB1,6)};pw3=(u32x4){PKW(pB1,8),PKW(pB1,10),PKW(pB1,12),PKW(pB1,14)};
    SBAR(); pv(o,vb0+sl_cur,PAF(0),PAF(1),PAF(2),PAF(3)); }
  #undef PKW
  #undef PAF
  #undef VFR
  #undef PIN
  #undef MX3
  #undef GAPA
  #undef GAPB
  #undef EX
  #undef VRD
  #undef KRD
  #undef STEP
  #undef CINIT
  #undef ENDW
  {auto rr=__builtin_amdgcn_permlane32_swap(__float_as_uint(l_reg),__float_as_uint(l_reg),false,false);l_reg=__uint_as_float(rr[0])+__uint_as_float(rr[1]);}
  if(hi==0)wsf[32+r32]=l_reg;asm volatile("s_waitcnt lgkmcnt(0)":::"memory");
  float rli[16];
  #pragma unroll
  for(int r=0;r<16;++r)rli[r]=__builtin_amdgcn_rcpf(wsf[32+crow(r,hi)]);
  bf16*Ow=O+(rowbase+q0+wid*QBLK)*DM+h*D;
  { bf16*stg=(bf16*)(shm+LDS_OST)+wid*2048;
    #pragma unroll
    for(int r=0;r<16;++r){const int orow=crow(r,hi);
      #pragma unroll
      for(int d0=0;d0<2;++d0)stg[orow*64+d0*32+r32]=__float2bfloat16(o[d0][r]*rli[r]);}
    asm volatile("s_waitcnt lgkmcnt(0)":::"memory");
    #pragma unroll
    for(int i=0;i<4;++i){const int row=i*8+(lane>>3),ch=lane&7; const u32x4 v=*(const u32x4*)(stg+row*64+ch*8); ATTN_STORE16(Ow+(long)row*DM+ch*8,v);} }
  asm volatile("s_waitcnt lgkmcnt(0)\n\ts_barrier":::"memory");
  #undef DMA_K
  #undef DMA_V
  #undef CMASK
  #undef START
  #undef RESC
  #undef ROT
}
constexpr int ATTN_LDS_BYTES=LDS_BYTES;
struct AttnTensors { const bf16* Q; const bf16* K; const bf16* V; bf16* O; const float* NCK; };
struct AttnUnit { int bh; int qb; };
struct StaticOrder {
  int vcu;
  __device__ __forceinline__ explicit StaticOrder(int grid,int block):vcu(grid==256?(block%8)*(grid/8)+block/8:block),grid_(grid){}
  int grid_;
  __device__ __forceinline__ bool next(int i,AttnUnit&u)const{
    if(grid_!=256){ const int L=i*grid_+vcu; if(L>=BATCH*NHEAD*NQB)return false; const int j=L/(BATCH*NHEAD); u.bh=L%(BATCH*NHEAD); u.qb=(j&1)?NQB-1-(j>>1):(j>>1); return true; }
    if(i>=4)return false; const int s=vcu&7; u.bh=vcu>>3; u.qb=(i==0)?s:(i==1)?15-s:(i==2)?16+s:31-s; return true; }
  __device__ __forceinline__ void a_ready(const AttnUnit&)const{}
  __device__ __forceinline__ void done(const AttnUnit&)const{}
};
template<class Sched,int THRL=8> __device__ __forceinline__ void attn_phase(char*lds,const AttnTensors&T,const Sched&S){
  AttnUnit u;
  for(int i=0;S.next(i,u);++i){ S.a_ready(u); attn_unit<THRL>(u.bh/NHEAD,u.bh%NHEAD,u.qb,T.Q,T.K,T.V,T.O,T.NCK,lds); S.done(u); }
}
#undef SBAR
#undef WAIT_BAR
}

#define GAS __attribute__((address_space(1)))
#define LAS __attribute__((address_space(3)))
typedef GAS unsigned gu32;
#define RLX_AGENT __ATOMIC_RELAXED, __HIP_MEMORY_SCOPE_AGENT
constexpr int NWAVES = 8;
constexpr int CW_BAR = 4096;
constexpr size_t CTL_ZERO_BYTES = 64 * 1024;
constexpr int LDS_BYTES = 147456;
constexpr int MISC_OFF = 131072 + 320;

#define XB_TMO      128
#define XB_XCNT(j)  (256  + 64 * (j))
#define XB_XSUB(j)  (1280 + 64 * (j))
#define XB_XGEN(j)  (2304 + 64 * (j))
#define XB_TOP      3328
#define XB_TOPGEN   3392
#define XCD_BAR_WORDS 3456
#define XB_SPIN_CAP (1u << 21)

__device__ __forceinline__ unsigned xb_ld(unsigned* p)              { return __hip_atomic_load(p, __ATOMIC_RELAXED, __HIP_MEMORY_SCOPE_AGENT); }
__device__ __forceinline__ unsigned xb_add(unsigned* p, unsigned v) { return __hip_atomic_fetch_add(p, v, __ATOMIC_RELAXED, __HIP_MEMORY_SCOPE_AGENT); }
__device__ __forceinline__ unsigned xb_xcc_id() { return (unsigned)__builtin_amdgcn_s_getreg((3 << 11) | 20) & 0xFu; }
#define XB_SPIN(cond, bar) do { unsigned _sp = 0; while (cond) { __builtin_amdgcn_s_sleep(1); \
    if ((++_sp & 255u) == 0u) { if (xb_ld(&(bar)[XB_TMO])) break; if (_sp > XB_SPIN_CAP) { atomicAdd(&(bar)[XB_TMO], 1u); break; } } } } while (0)

struct XcdBarrier {
    unsigned* bar; unsigned x;
    volatile LAS unsigned* st;
};

__device__ __forceinline__ XcdBarrier xcd_barrier_post(unsigned* bar, volatile LAS unsigned* st) {
    XcdBarrier b; b.bar = bar; b.x = xb_xcc_id(); b.st = st;
    if (threadIdx.x == 0) (void)xb_add(&bar[XB_XCNT(b.x)], 1u);
    return b;
}
__device__ __forceinline__ void xcd_barrier_complete(unsigned* bar, unsigned x, unsigned& nloc, unsigned& nx) {
    const unsigned G = gridDim.x * gridDim.y * gridDim.z;
    unsigned sum, cnt, mine, sp = 0u;
    for (;;) {
        sum = 0u; cnt = 0u; mine = 0u;
#pragma unroll
        for (unsigned j = 0; j < 16; ++j) { const unsigned c = xb_ld(&bar[XB_XCNT(j)]); sum += c; cnt += (c > 0u) ? 1u : 0u; mine = (j == x) ? c : mine; }
        if (sum == G) break;
        __builtin_amdgcn_s_sleep(1);
        if ((++sp & 255u) == 0u) { if (xb_ld(&bar[XB_TMO])) break; if (sp > XB_SPIN_CAP) { atomicAdd(&bar[XB_TMO], 1u); break; } }
    }
    nloc = mine > 0u ? mine : 1u; nx = cnt > 0u ? cnt : 1u;
}

__device__ __forceinline__ void xcd_barrier(const XcdBarrier& b) {
    asm volatile("s_waitcnt vmcnt(0)" ::: "memory");
    __syncthreads();
    if (threadIdx.x == 0) {
        unsigned* bar = b.bar;
        __builtin_amdgcn_s_waitcnt(0);
        unsigned nloc = b.st[0], nx = b.st[1];
        if (nloc == 0u) { xcd_barrier_complete(bar, b.x, nloc, nx); b.st[0] = nloc; b.st[1] = nx; }
        const unsigned old = xb_add(&bar[XB_XSUB(b.x)], 1u);
        const unsigned gen = old / nloc;
        if (old + 1u == (gen + 1u) * nloc) {
            __builtin_amdgcn_fence(__ATOMIC_RELEASE, "agent");
            asm volatile("s_waitcnt vmcnt(0)" ::: "memory");
            const unsigned og = xb_add(&bar[XB_TOP], 1u);
            const unsigned tg = og / nx;
            if (og + 1u == (tg + 1u) * nx) xb_add(&bar[XB_TOPGEN], 1u);
            else XB_SPIN(xb_ld(&bar[XB_TOPGEN]) == tg, bar);
            __builtin_amdgcn_fence(__ATOMIC_ACQUIRE, "agent");
            xb_add(&bar[XB_XGEN(b.x)], 1u);
            asm volatile("s_waitcnt vmcnt(0)" ::: "memory");
        } else {
            XB_SPIN(xb_ld(&bar[XB_XGEN(b.x)]) == gen, bar);
            __builtin_amdgcn_fence(__ATOMIC_ACQUIRE, "agent");
            asm volatile("s_waitcnt vmcnt(0)" ::: "memory");
        }
    }
    __syncthreads();
}


struct Args { const float* in[25]; float* out; unsigned char* ws; };
static_assert(sizeof(Args) == 27 * 8, "Args has no padding");

struct Ctx { int gw, NGW, lane, wave, tid; LAS unsigned char* lds; };
__device__ __forceinline__ Ctx mkctx(LAS unsigned char* lds) {
    int t = threadIdx.x; asm volatile("" : "+v"(t));
    Ctx C; C.tid = t; C.lane = t & 63; C.wave = __builtin_amdgcn_readfirstlane(t >> 6); C.gw = blockIdx.x * NWAVES + C.wave; C.NGW = gridDim.x * NWAVES; C.lds = lds; return C;
}

__device__ __forceinline__ void ph_mod(const Ctx& C, const float* __restrict__ c, const float* __restrict__ mod_w, const float* __restrict__ mod_b, float* __restrict__ MOD) {
    LAS float* red = (LAS float*)C.lds;
    for (int it = blockIdx.x; it < DEPTH * 6 * D / 64; it += gridDim.x) {
        const int idx = it * 64 + C.lane, l = idx / (6 * D), m = idx % (6 * D);
        const float* w = mod_w + (size_t)l * D * 6 * D + m;
        float a0 = 0.f, a1 = 0.f;
        const int d0 = C.wave * 128;
#pragma unroll 16
        for (int d = d0; d < d0 + 128; ++d) { const float wv = w[(size_t)d * 6 * D]; a0 += silu_f(c[d]) * wv; a1 += silu_f(c[D + d]) * wv; }
        red[(C.wave * 2 + 0) * 64 + C.lane] = a0; red[(C.wave * 2 + 1) * 64 + C.lane] = a1;
        __syncthreads();
        if (C.wave < 2) {
            float s = 0.f;
#pragma unroll
            for (int w8 = 0; w8 < 8; ++w8) s += red[(w8 * 2 + C.wave) * 64 + C.lane];
            MOD[((size_t)l * 2 + C.wave) * 6 * D + m] = s + mod_b[idx];
        }
        __syncthreads();
    }
}

__device__ __forceinline__ void ph_modulate(const Ctx& C, const float* __restrict__ x, const float* __restrict__ MODl, bf16* __restrict__ Hout) {
    for (int row = C.gw; row < M; row += C.NGW) {
        const int lane = C.lane, b = row / S;
        const float* sh = MODl + (size_t)b * 6 * D; const float* sc = sh + D;
#pragma unroll
        for (int i = 0; i < 4; ++i) {
            const int col = lane * 4 + 256 * i;
            const f32x4 xv = *(const f32x4*)(x + (size_t)row * D + col), s1 = *(const f32x4*)(sc + col), s0 = *(const f32x4*)(sh + col);
            const f32x4 h = xv * (1.f + s1) + s0;
            u32x2 w; w.x = pk2(h[0], h[1]); w.y = pk2(h[2], h[3]);
            *(u32x2*)(Hout + (size_t)row * D + col) = w;
        }
    }
}

#define LDS_WAIT() asm volatile("s_waitcnt lgkmcnt(0)" ::: "memory")
__device__ __forceinline__ void cvt_item(const float* __restrict__ W, int ldw, int K, bf16* __restrict__ WT, int nblk, int item, int swiglu, LAS float* scr, int lane) {
    const int kb = item / nblk, nb = item % nblk, k0 = 64 * kb, n0 = 32 * nb;
    int drow0 = n0;
    if (swiglu) { const int j = (n0 < F) ? n0 : n0 - F; drow0 = 256 * (j >> 7) + (j & 127) + ((n0 < F) ? 0 : 128); }
#pragma unroll 8
    for (int i = 0; i < 32; ++i) { const int kk = 2 * i + (lane >> 5); scr[kk * 33 + (lane & 31)] = W[(size_t)(k0 + kk) * ldw + n0 + (lane & 31)]; }
    LDS_WAIT(); asm volatile("" ::: "memory");
    const int c = lane & 7;
#pragma unroll
    for (int j = 0; j < 4; ++j) { const int n = (lane >> 3) + 8 * j; const LAS float* sp = scr + (8 * c) * 33 + n;
        u32x4 o; o.x = pk2(sp[0 * 33], sp[1 * 33]); o.y = pk2(sp[2 * 33], sp[3 * 33]); o.z = pk2(sp[4 * 33], sp[5 * 33]); o.w = pk2(sp[6 * 33], sp[7 * 33]);
        *(u32x4*)(WT + (size_t)(drow0 + n) * K + k0 + 8 * c) = o; }
    LDS_WAIT(); asm volatile("" ::: "memory");
}
struct CvtPtrs { const float *gm_in, *gm_out, *fox_in, *fox_out, *pool_in, *pool_out, *pool_grp, *ffn13, *ffn2, *moe13, *moe2; unsigned char* ws; };
__device__ __forceinline__ void ph_convert(const Ctx& C, const CvtPtrs& P) {
    LAS float* scr = (LAS float*)(C.lds + C.wave * 16384);
#define CVT_PER(K_, N_) (((K_) / 64) * ((N_) / 32))
    constexpr int NITEMS = 2 * CVT_PER(D, 4096) + 2 * CVT_PER(GW, D) + CVT_PER(D, 3 * D) + 3 * CVT_PER(D, D) + 4 * CVT_PER(256, 256) + 2 * CVT_PER(D, 2 * F) + 2 * CVT_PER(F, D) + 16 * CVT_PER(D, 2 * F) + 16 * CVT_PER(F, D);
#define CVT_CLASS(Wp, WTOFF, NMAT, K_, LDW, N_, SW) { constexpr int per = CVT_PER(K_, N_), tot = per * (NMAT); \
        if (r < tot) { const int mi = r / per, it2 = r % per; cvt_item((Wp) + (size_t)mi * (K_) * (LDW), LDW, K_, (bf16*)(P.ws + (WTOFF)) + (size_t)mi * (N_) * (K_), (N_) / 32, it2, SW, scr, C.lane); continue; } r -= tot; }
    for (int it = C.gw; it < NITEMS; it += C.NGW) {
        int r = it;
        CVT_CLASS(P.gm_in, WT_GM_IN, 2, D, 4096, 4096, 0)
        CVT_CLASS(P.gm_out, WT_GM_OUT, 2, GW, D, D, 0)
        CVT_CLASS(P.fox_in, WT_FOX_IN, 1, D, 3 * D + H, 3 * D, 0)
        CVT_CLASS(P.fox_out, WT_FOX_OUT, 1, D, D, D, 0)
        CVT_CLASS(P.pool_in, WT_POOL_IN, 1, D, D, D, 0)
        CVT_CLASS(P.pool_out, WT_POOL_OUT, 1, D, D, D, 0)
        CVT_CLASS(P.pool_grp, WT_POOL_GRP, 4, 256, 256, 256, 0)
        CVT_CLASS(P.ffn13, WT_FFN13, 2, D, 2 * F, 2 * F, 1)
        CVT_CLASS(P.ffn2, WT_FFN2, 2, F, D, D, 0)
        CVT_CLASS(P.moe13, WT_MOE13, 16, D, 2 * F, 2 * F, 1)
        CVT_CLASS(P.moe2, WT_MOE2, 16, F, D, D, 0)
    }
#undef CVT_CLASS
#undef CVT_PER
}

struct LnArgs {
    const float* xin; const float* y; float* xout; bf16* hout;
    const float* gate;
    const float* gamma; const float* beta;
    const float* nsh;
    const bf16* ys; const int* tok_e; const int* tok_pos; const float* tok_g; const int* cnt;
};
__device__ __forceinline__ void ph_ln(const Ctx& C, const LnArgs& a) {
    for (int row = C.gw; row < M; row += C.NGW) {
        const int lane = C.lane, b = row / S;
        const float* g = a.gate + (size_t)b * 6 * D;
        f32x4 v[4]; float s = 0.f;
        size_t r0 = 0, r1 = 0; float g0 = 0.f, g1 = 0.f;
        if (a.ys) {
            const int e0 = a.tok_e[row * 2], e1 = a.tok_e[row * 2 + 1];
            int o0 = 0, o1 = 0;
            for (int e = 0; e < NE; ++e) { const int c = ((a.cnt[e] + 255) >> 8) << 8; if (e < e0) o0 += c; if (e < e1) o1 += c; }
            r0 = (size_t)(o0 + a.tok_pos[row * 2]) * D; r1 = (size_t)(o1 + a.tok_pos[row * 2 + 1]) * D;
            g0 = a.tok_g[row * 2]; g1 = a.tok_g[row * 2 + 1];
        }
#pragma unroll
        for (int i = 0; i < 4; ++i) {
            const int col = lane * 4 + 256 * i;
            const f32x4 xv = *(const f32x4*)(a.xin + (size_t)row * D + col);
            f32x4 yv;
            if (a.ys) {
                const u32x2 w0 = *(const u32x2*)(a.ys + r0 + col), w1 = *(const u32x2*)(a.ys + r1 + col);
                yv[0] = g0 * bf2f(w0.x & 0xffff) + g1 * bf2f(w1.x & 0xffff); yv[1] = g0 * bf2f(w0.x >> 16) + g1 * bf2f(w1.x >> 16);
                yv[2] = g0 * bf2f(w0.y & 0xffff) + g1 * bf2f(w1.y & 0xffff); yv[3] = g0 * bf2f(w0.y >> 16) + g1 * bf2f(w1.y >> 16);
            } else yv = *(const f32x4*)(a.y + (size_t)row * D + col);
            const f32x4 gv = *(const f32x4*)(g + col);
            v[i] = DN_ALPHA * xv + (1.f + gv) * yv;
            s += (v[i][0] + v[i][1]) + (v[i][2] + v[i][3]);
        }
        const float mean = wave_sum(s) * (1.f / D); float s2 = 0.f;
#pragma unroll
        for (int i = 0; i < 4; ++i) { v[i] = v[i] - mean; s2 += (v[i][0] * v[i][0] + v[i][1] * v[i][1]) + (v[i][2] * v[i][2] + v[i][3] * v[i][3]); }
        const float rstd = 1.f / sqrtf(wave_sum(s2) * (1.f / D) + LN_EPS);
#pragma unroll
        for (int i = 0; i < 4; ++i) {
            const int col = lane * 4 + 256 * i;
            const f32x4 o = v[i] * rstd * *(const f32x4*)(a.gamma + col) + *(const f32x4*)(a.beta + col);
            *(f32x4*)(a.xout + (size_t)row * D + col) = o;
            if (a.hout) {
                const float* sh = a.nsh + (size_t)b * 6 * D; const float* sc = sh + D;
                const f32x4 h = o * (1.f + *(const f32x4*)(sc + col)) + *(const f32x4*)(sh + col);
                u32x2 w; w.x = pk2(h[0], h[1]); w.y = pk2(h[2], h[3]);
                *(u32x2*)(a.hout + (size_t)row * D + col) = w;
            }
        }
    }
}

enum { EP_F32 = 0, EP_BF16 = 1, EP_GELU = 2, EP_SWIGLU = 3, EP_QKV = 4 };
struct GF {
    const bf16* A;
    const int* gather;
    const int* cnt;
    const float* B; size_t bz;
    void* out;
    const float* colscale;
    int lda, K, Mrows;
    int a_compact;
    int ldb, mode, ldo;
    int grouped;
};
__device__ __forceinline__ void ph_gemm(const Ctx& C, const GF& f, int ncg, int nz) {
    const int lane = C.lane, fr = lane & 15, fq = lane >> 4;
    const int nrg = f.Mrows / 16;
    const long total = (long)nrg * ncg * nz;
    for (long item = C.gw; item < total; item += C.NGW) {
        const int rg = (int)(item % nrg), cg = (int)((item / nrg) % ncg), z = (int)(item / ((long)nrg * ncg));
        int nrows = f.Mrows, obase = 0;
        if (f.cnt) { nrows = f.cnt[z]; for (int e = 0; e < z; ++e) obase += ((f.cnt[e] + 255) >> 8) << 8; }
        const int row0 = rg * 16;
        if (row0 >= nrows) continue;
        int r = row0 + fr; const bool rvalid = r < nrows; if (!rvalid) r = nrows - 1;
        size_t arow = (size_t)r;
        if (f.gather) arow = (size_t)z * M + r; else if (f.a_compact) arow = (size_t)(obase + r);
        const bf16* ap = f.A + arow * f.lda + fq * 8;
        const float* Bz = f.B + (size_t)z * f.bz;
        int col[4];
#pragma unroll
        for (int t = 0; t < 4; ++t) col[t] = (f.mode == EP_SWIGLU) ? ((t < 2) ? 32 * cg + 16 * t : F + 32 * cg + 16 * (t - 2)) : 64 * cg + 16 * t;
        const float* bp[4];
        if (f.grouped) { const int g = (64 * cg) >> 8; ap += g * 256; Bz += (size_t)g * 256 * 256;
#pragma unroll
            for (int t = 0; t < 4; ++t) bp[t] = Bz + (size_t)(fq * 8) * f.ldb + (col[t] - 256 * g) + fr;
        } else {
#pragma unroll
            for (int t = 0; t < 4; ++t) bp[t] = Bz + (size_t)(fq * 8) * f.ldb + col[t] + fr;
        }
        f32x4 acc[4];
#pragma unroll
        for (int t = 0; t < 4; ++t) acc[t] = (f32x4){0.f, 0.f, 0.f, 0.f};
        const int K = f.K; const size_t ldb = (size_t)f.ldb;
        for (int k0 = 0; k0 < K; k0 += 32) {
            const bf16x8 af = *(const bf16x8*)(ap + k0);
#pragma unroll
            for (int t = 0; t < 4; ++t) {
                bf16x8 bfr;
#pragma unroll
                for (int j = 0; j < 8; ++j) bfr[j] = (short)f2bf(bp[t][(size_t)(k0 + j) * ldb]);
                acc[t] = __builtin_amdgcn_mfma_f32_16x16x32_bf16(bfr, af, acc[t], 0, 0, 0);
            }
        }
        if (!rvalid) continue;
        r = row0 + fr;
        const size_t orow = (size_t)(f.cnt ? obase + r : r);
        if (f.mode == EP_SWIGLU) {
#pragma unroll
            for (int t = 0; t < 2; ++t) {
                float o[4];
#pragma unroll
                for (int i = 0; i < 4; ++i) o[i] = silu_f(acc[t][i]) * acc[t + 2][i];
                u32x2 w; w.x = pk2(o[0], o[1]); w.y = pk2(o[2], o[3]);
                *(u32x2*)((bf16*)f.out + orow * f.ldo + 32 * cg + 16 * t + 4 * fq) = w;
            }
            continue;
        }
#pragma unroll
        for (int t = 0; t < 4; ++t) {
            const int c = col[t] + 4 * fq;
            f32x4 v = acc[t];
            if (f.mode == EP_F32) { *(f32x4*)((float*)f.out + orow * f.ldo + c) = v; continue; }
            if (f.mode == EP_GELU) { v[0] = gelu_f(v[0]); v[1] = gelu_f(v[1]); v[2] = gelu_f(v[2]); v[3] = gelu_f(v[3]); }
            if (f.colscale) v = v * *(const f32x4*)(f.colscale + c);
            bf16* o = (bf16*)f.out; int cc = c;
            if (f.mode == EP_QKV) { const int which = c >> 10; cc = c & 1023; o += (size_t)which * M * D; if (which == 0) v = v * QSCALE; }
            u32x2 w; w.x = pk2(v[0], v[1]); w.y = pk2(v[2], v[3]);
            *(u32x2*)(o + orow * f.ldo + cc) = w;
        }
    }
}

__device__ __forceinline__ void ph_vln(const Ctx& C, const bf16* __restrict__ Z, const float* __restrict__ g, const float* __restrict__ bb, bf16* __restrict__ VLN) {
    for (int row = C.gw; row < M; row += C.NGW) {
        const int lane = C.lane;
        float v[32]; float s = 0.f;
#pragma unroll
        for (int i = 0; i < 4; ++i) {
            const u32x4 w = *(const u32x4*)(Z + (size_t)row * 4096 + GW + lane * 8 + 512 * i);
#pragma unroll
            for (int j = 0; j < 4; ++j) { v[i * 8 + 2 * j] = bf2f(w[j] & 0xffff); v[i * 8 + 2 * j + 1] = bf2f(w[j] >> 16); }
        }
#pragma unroll
        for (int i = 0; i < 32; ++i) s += v[i];
        const float mean = wave_sum(s) * (1.f / GW); float s2 = 0.f;
#pragma unroll
        for (int i = 0; i < 32; ++i) { v[i] -= mean; s2 += v[i] * v[i]; }
        const float rstd = 1.f / sqrtf(wave_sum(s2) * (1.f / GW) + LN_EPS);
#pragma unroll
        for (int i = 0; i < 4; ++i) {
            const int c0 = lane * 8 + 512 * i; u32x4 w;
#pragma unroll
            for (int j = 0; j < 4; ++j) w[j] = pk2(v[i * 8 + 2 * j] * rstd * g[c0 + 2 * j] + bb[c0 + 2 * j], v[i * 8 + 2 * j + 1] * rstd * g[c0 + 2 * j + 1] + bb[c0 + 2 * j + 1]);
            *(u32x4*)(VLN + (size_t)row * GW + c0) = w;
        }
    }
}
__device__ __forceinline__ void ph_mix(const Ctx& C, const bf16* __restrict__ Z, const bf16* __restrict__ VLN, const float* __restrict__ ws_, const float* __restrict__ bs, bf16* __restrict__ G) {
    LAS bf16* tile = (LAS bf16*)C.lds;
    const int c = C.tid & 255, th = C.tid >> 8;
    for (int it = blockIdx.x; it < (M / CH) * GMG; it += gridDim.x) {
        const int chunk = it / GMG, g = it % GMG;
        const size_t row0 = (size_t)chunk * CH;
        for (int s = th * 64; s < th * 64 + 64; ++s) tile[s * 256 + c] = VLN[(row0 + s) * GW + g * 256 + c];
        __syncthreads();
        const float* w = ws_ + (size_t)g * CH * CH;
        for (int t = th * 64; t < th * 64 + 64; ++t) {
            float acc = 0.f;
            for (int s = 0; s <= t; ++s) acc += w[t * CH + s] * bf2f(tile[s * 256 + c]);
            acc += bs[g * CH + t];
            const float u = bf2f(Z[(row0 + t) * 4096 + g * 256 + c]);
            G[(row0 + t) * GW + g * 256 + c] = (bf16)f2bf(u * acc);
        }
        __syncthreads();
    }
}

__device__ __forceinline__ void ph_flogit(const Ctx& C, const float* __restrict__ X, const float* __restrict__ MODl, const float* __restrict__ w_in, const float* __restrict__ b_f, float* __restrict__ LF) {
    for (int row = C.gw; row < M; row += C.NGW) {
        const int lane = C.lane, b = row / S;
        const float* sh = MODl + (size_t)b * 6 * D; const float* sc = sh + D;
        float acc[16];
#pragma unroll
        for (int j = 0; j < 16; ++j) acc[j] = 0.f;
        for (int i = 0; i < 16; ++i) {
            const int d = lane + 64 * i;
            const float hv = X[(size_t)row * D + d] * (1.f + sc[d]) + sh[d];
            const float* wr = w_in + (size_t)d * (3 * D + H) + 3 * D;
#pragma unroll
            for (int j = 0; j < 16; ++j) acc[j] += hv * wr[j];
        }
#pragma unroll
        for (int j = 0; j < 16; ++j) acc[j] = wave_sum(acc[j]);
        if (lane < 16) {
            float zz = 0.f;
#pragma unroll
            for (int j = 0; j < 16; ++j) if (lane == j) zz = acc[j];
            zz += b_f[lane];
            const float ls = (zz >= 0.f) ? -log1pf(__expf(-zz)) : zz - log1pf(__expf(zz));
            LF[(size_t)row * 16 + lane] = ls;
        }
    }
}
__device__ __forceinline__ void ph_fscan(const Ctx& C, const float* __restrict__ LF, float* __restrict__ CUM) {
    for (int bh = C.gw; bh < NB * H; bh += C.NGW) {
        const int b = bh / H, h = bh % H, lane = C.lane;
        const int per = S / 64;
        float s = 0.f;
        for (int i = 0; i < per; ++i) s += LF[((size_t)b * S + lane * per + i) * 16 + h];
        float incl = s;
#pragma unroll
        for (int o = 1; o < 64; o <<= 1) { const float t = __shfl_up(incl, o); if (lane >= o) incl += t; }
        float run = incl - s;
        for (int i = 0; i < per; ++i) { run += LF[((size_t)b * S + lane * per + i) * 16 + h]; CUM[(size_t)bh * S + lane * per + i] = -run * LOG2E; }
    }
}
__device__ __forceinline__ void ph_attn(const Ctx& C, const bf16* __restrict__ Q, const bf16* __restrict__ Kb, const bf16* __restrict__ Vb, const float* __restrict__ CUM, bf16* __restrict__ AO) {
    for (int gq = C.gw; gq < NB * H * S; gq += C.NGW) {
        const int lane = C.lane;
        const int t = gq % S, bh = gq / S, b = bh / H, h = bh % H;
        const size_t rowb = (size_t)b * S;
        float q[64];
        {
            const bf16* qp = Q + (rowb + t) * D + h * HD;
#pragma unroll
            for (int i = 0; i < 8; ++i) { const u32x4 w = *(const u32x4*)(qp + 8 * i);
#pragma unroll
                for (int j = 0; j < 4; ++j) { q[8 * i + 2 * j] = bf2f(w[j] & 0xffff); q[8 * i + 2 * j + 1] = bf2f(w[j] >> 16); } }
        }
        const float* cum = CUM + (size_t)bh * S;
        const float cq = -cum[t];
        float m = -INFINITY, l = 0.f, o = 0.f;
        for (int kb = 0; kb <= t; kb += 64) {
            const int key = kb + lane; const bool valid = key <= t;
            float s = -INFINITY;
            if (valid) {
                const bf16* kp = Kb + (rowb + key) * D + h * HD; float dot = 0.f;
#pragma unroll
                for (int i = 0; i < 8; ++i) { const u32x4 w = *(const u32x4*)(kp + 8 * i);
#pragma unroll
                    for (int j = 0; j < 4; ++j) { dot += q[8 * i + 2 * j] * bf2f(w[j] & 0xffff); dot += q[8 * i + 2 * j + 1] * bf2f(w[j] >> 16); } }
                s = dot + cq + cum[key];
            }
            const float mnew = fmaxf(m, wave_max(s));
            const float p = valid ? exp2f(s - mnew) : 0.f;
            const float corr = exp2f(m - mnew);
            l = l * corr + wave_sum(p); o *= corr;
            const int nk = (t - kb + 1 < 64) ? (t - kb + 1) : 64;
            for (int j = 0; j < nk; ++j) { const float pj = __shfl(p, j); o += pj * bf2f(Vb[(rowb + kb + j) * D + h * HD + lane]); }
            m = mnew;
        }
        AO[(rowb + t) * D + h * HD + lane] = (bf16)f2bf(o / l);
    }
}

__device__ __forceinline__ void ph_pool(const Ctx& C, const bf16* __restrict__ PZ, bf16* __restrict__ PP) {
    const size_t nthr = (size_t)gridDim.x * (NWAVES * 64);
    for (size_t idx = (size_t)blockIdx.x * (NWAVES * 64) + C.tid; idx < (size_t)M * D; idx += nthr) {
        const int row = (int)(idx >> 10), col = (int)(idx & 1023), pos = row % S;
        const int win = 2 << (col >> 8);
        const int cntw = (pos + 1 < win) ? pos + 1 : win;
        float s = 0.f;
        for (int j = 0; j < cntw; ++j) s += bf2f(PZ[(size_t)(row - j) * D + col]);
        const float zc = bf2f(PZ[idx]);
        PP[idx] = (bf16)f2bf(s / (float)cntw - zc);
    }
}

__device__ __forceinline__ void ph_route(const Ctx& C, const float* __restrict__ X, const float* __restrict__ MODl, const float* __restrict__ wr, const float* __restrict__ br,
                                         int* __restrict__ cnt, int* __restrict__ tok_e, float* __restrict__ tok_g, int* __restrict__ tok_pos, bf16* __restrict__ XS) {
    for (int row = C.gw; row < M; row += C.NGW) {
        const int lane = C.lane, b = row / S;
        const float* sh = MODl + (size_t)b * 6 * D + 3 * D; const float* sc = sh + D;
        float acc[8];
#pragma unroll
        for (int j = 0; j < 8; ++j) acc[j] = 0.f;
        u32x2 hw[4];
#pragma unroll
        for (int i = 0; i < 4; ++i) {
            const int col = lane * 4 + 256 * i;
            const f32x4 xv = *(const f32x4*)(X + (size_t)row * D + col);
            const f32x4 h = xv * (1.f + *(const f32x4*)(sc + col)) + *(const f32x4*)(sh + col);
            hw[i].x = pk2(h[0], h[1]); hw[i].y = pk2(h[2], h[3]);
#pragma unroll
            for (int j = 0; j < 4; ++j) {
                const f32x4 w0 = *(const f32x4*)(wr + (size_t)(col + j) * 8), w1 = *(const f32x4*)(wr + (size_t)(col + j) * 8 + 4);
                acc[0] += h[j] * w0[0]; acc[1] += h[j] * w0[1]; acc[2] += h[j] * w0[2]; acc[3] += h[j] * w0[3];
                acc[4] += h[j] * w1[0]; acc[5] += h[j] * w1[1]; acc[6] += h[j] * w1[2]; acc[7] += h[j] * w1[3];
            }
        }
#pragma unroll
        for (int j = 0; j < 8; ++j) acc[j] = wave_sum(acc[j]) + br[j];
        int e0 = 0; float v0 = acc[0];
#pragma unroll
        for (int j = 1; j < 8; ++j) if (acc[j] > v0) { v0 = acc[j]; e0 = j; }
        int e1 = -1; float v1 = -INFINITY;
#pragma unroll
        for (int j = 0; j < 8; ++j) if (j != e0 && acc[j] > v1) { v1 = acc[j]; e1 = j; }
        int p0 = 0, p1 = 0;
        if (lane == 0) {
            const float ex = __expf(v1 - v0), g0 = 1.f / (1.f + ex), g1 = ex / (1.f + ex);
            p0 = atomicAdd(&cnt[e0], 1); p1 = atomicAdd(&cnt[e1], 1);
            tok_e[row * 2] = e0; tok_e[row * 2 + 1] = e1; tok_g[row * 2] = g0; tok_g[row * 2 + 1] = g1; tok_pos[row * 2] = p0; tok_pos[row * 2 + 1] = p1;
        }
        p0 = __builtin_amdgcn_readfirstlane(p0); p1 = __builtin_amdgcn_readfirstlane(p1);
        e0 = __builtin_amdgcn_readfirstlane(e0); e1 = __builtin_amdgcn_readfirstlane(e1);
        bf16* d0 = XS + ((size_t)e0 * M + p0) * D; bf16* d1 = XS + ((size_t)e1 * M + p1) * D;
#pragma unroll
        for (int i = 0; i < 4; ++i) { const int col = lane * 4 + 256 * i; *(u32x2*)(d0 + col) = hw[i]; *(u32x2*)(d1 + col) = hw[i]; }
    }
}

__device__ __forceinline__ GF mkgf(const bf16* A, int lda, int K, const float* B, int ldb, int mode, void* out, int ldo) {
    GF f; f.A = A; f.gather = nullptr; f.cnt = nullptr; f.B = B; f.bz = 0; f.out = out; f.colscale = nullptr; f.lda = lda; f.K = K; f.Mrows = M; f.a_compact = 0; f.ldb = ldb; f.mode = mode; f.ldo = ldo; f.grouped = 0; return f;
}
__global__ void __launch_bounds__(NWAVES * 64, 2) mega_fwd(Args args) {
    extern __shared__ __attribute__((aligned(16))) unsigned char lds_raw[];
    LAS unsigned char* const ldsb = (LAS unsigned char*)lds_raw;
    volatile LAS unsigned* MISC = (volatile LAS unsigned*)(ldsb + MISC_OFF);
    if (threadIdx.x < 32) MISC[threadIdx.x] = 0u;
    __syncthreads();
    unsigned char* ws = args.ws;
    XcdBarrier bar = xcd_barrier_post((unsigned*)(ws + WS_CTL) + CW_BAR, MISC + 8);
#define GRID_BAR() xcd_barrier(bar)

    const float* x = args.in[0]; const float* c = args.in[1]; const float* mod_w = args.in[2]; const float* mod_b = args.in[3];
    const float* ln_g = args.in[4]; const float* ln_b = args.in[5];
    const float* gm_w_in = args.in[6]; const float* gm_ln_g = args.in[7]; const float* gm_ln_b = args.in[8];
    const float* gm_w_s = args.in[9]; const float* gm_b_s = args.in[10]; const float* gm_w_out = args.in[11];
    const float* fox_w_in = args.in[12]; const float* fox_b_f = args.in[13]; const float* fox_w_out = args.in[14];
    const float* pool_w_in = args.in[15]; const float* pool_w_grp = args.in[16]; const float* pool_scale = args.in[17]; const float* pool_w_out = args.in[18];
    const float* ffn_w13 = args.in[19]; const float* ffn_w2 = args.in[20];
    const float* moe_wr = args.in[21]; const float* moe_br = args.in[22]; const float* moe_w13 = args.in[23]; const float* moe_w2 = args.in[24];
    int* ctl = (int*)(ws + WS_CTL); float* MOD = (float*)(ws + WS_MOD); float* X = (float*)(ws + WS_X); float* Y = (float*)(ws + WS_Y);
    bf16* Hb = (bf16*)(ws + WS_H); bf16* Z = (bf16*)(ws + WS_Z); bf16* VLN = (bf16*)(ws + WS_VLN); bf16* G = (bf16*)(ws + WS_G); bf16* ACT = (bf16*)(ws + WS_ACT);
    bf16* Qb = (bf16*)(ws + WS_Q); bf16* Kb = Qb + (size_t)M * D; bf16* Vb = Kb + (size_t)M * D; bf16* AO = (bf16*)(ws + WS_AO);
    float* LF = (float*)(ws + WS_LF); float* CUM = (float*)(ws + WS_CUM);
    bf16* PZ = (bf16*)(ws + WS_PZ); bf16* PP = (bf16*)(ws + WS_PP); bf16* PG = (bf16*)(ws + WS_PG); bf16* YS = (bf16*)(ws + WS_YS);
    int* tok_e = (int*)(ws + WS_RT); float* tok_g = (float*)(ws + WS_RT + 128 * 1024); int* tok_pos = (int*)(ws + WS_RT + 256 * 1024); int* list = (int*)(ws + WS_RT + 512 * 1024);

    float* VST = (float*)(ws + WS_VST); bf16* XS = (bf16*)(ws + WS_XS);
    const int G_ = (int)gridDim.x;
#ifndef FAST_GEMM
#define FAST_GEMM 1
#endif
#define FASTG(EPI, SCHED, ALIGN, Aptr, WTptr, lda_, K_, Nn_, Einit, Sextra) do { pg8::Gemm g{(const pg8::bf16_t*)(Aptr), (const pg8::bf16_t*)(WTptr), (lda_), (K_)}; \
        SCHED S_; S_.init(M, (Nn_), G_, (int)blockIdx.x); Sextra; EPI E_ Einit; pg8::gemm_phase<EPI, SCHED, ALIGN, true>(ldsb, g, S_, E_); } while (0)
    ph_mod(mkctx(ldsb), c, mod_w, mod_b, MOD);
#if FAST_GEMM
    { CvtPtrs P; P.gm_in = gm_w_in; P.gm_out = gm_w_out; P.fox_in = fox_w_in; P.fox_out = fox_w_out; P.pool_in = pool_w_in; P.pool_out = pool_w_out; P.pool_grp = pool_w_grp;
      P.ffn13 = ffn_w13; P.ffn2 = ffn_w2; P.moe13 = moe_w13; P.moe2 = moe_w2; P.ws = ws; ph_convert(mkctx(ldsb), P); }
#endif
    GRID_BAR();
    ph_modulate(mkctx(ldsb), x, MOD, Hb); GRID_BAR();

#define LN_PHASE(i_, sub_, xin_, last_) do { LnArgs a; a.xin = (xin_); a.y = Y; a.xout = (last_) ? args.out : X; a.hout = (last_) ? nullptr : Hb; \
        a.gate = MOD + (size_t)(i_) * 2 * 6 * D + ((sub_) ? 5 : 2) * D; a.gamma = ln_g + (size_t)((i_) * 2 + (sub_)) * D; a.beta = ln_b + (size_t)((i_) * 2 + (sub_)) * D; \
        a.nsh = (sub_) ? MOD + (size_t)((i_) + 1) * 2 * 6 * D : MOD + (size_t)(i_) * 2 * 6 * D + 3 * D; \
        a.ys = nullptr; a.tok_e = nullptr; a.tok_pos = nullptr; a.tok_g = nullptr; a.cnt = nullptr; ph_ln(mkctx(ldsb), a); GRID_BAR(); } while (0)
#define GMLP(i_, j_, xin_) do { \
        if (FAST_GEMM) FASTG(pg8::EpiBf16<1>, pg8::SchedPlain, true, Hb, ws + WT_GM_IN + (size_t)(j_) * 4096 * D * 2, D, D, 4096, ({Z, 4096, 0, (size_t)0, 1.f, nullptr, VST, 8}), S_.btoff = 0); \
        else { GF f = mkgf(Hb, D, D, gm_w_in + (size_t)(j_) * D * 4096, 4096, EP_GELU, Z, 4096); ph_gemm(mkctx(ldsb), f, 4096 / 64, 1); } GRID_BAR(); \
        ph_vln(mkctx(ldsb), Z, gm_ln_g + (size_t)(j_) * GW, gm_ln_b + (size_t)(j_) * GW, VLN); GRID_BAR(); \
        ph_mix(mkctx(ldsb), Z, VLN, gm_w_s + (size_t)(j_) * GMG * CH * CH, gm_b_s + (size_t)(j_) * GMG * CH, G); GRID_BAR(); \
        if (FAST_GEMM) FASTG(pg8::EpiF32, pg8::SchedPlain, true, G, ws + WT_GM_OUT + (size_t)(j_) * D * GW * 2, GW, GW, D, ({Y, D}), S_.btoff = 0); \
        else { GF f = mkgf(G, GW, GW, gm_w_out + (size_t)(j_) * GW * D, D, EP_F32, Y, D); ph_gemm(mkctx(ldsb), f, D / 64, 1); } GRID_BAR(); \
        LN_PHASE(i_, 0, xin_, false); } while (0)
#define FFN(i_, fi_, last_) do { \
        if (FAST_GEMM) FASTG(pg8::EpiSwiglu, pg8::SchedPlain, true, Hb, ws + WT_FFN13 + (size_t)(fi_) * 2 * F * D * 2, D, D, 2 * F, ({ACT, F}), S_.btoff = 0); \
        else { GF f = mkgf(Hb, D, D, ffn_w13 + (size_t)(fi_) * D * 2 * F, 2 * F, EP_SWIGLU, ACT, F); ph_gemm(mkctx(ldsb), f, F / 32, 1); } GRID_BAR(); \
        if (FAST_GEMM) FASTG(pg8::EpiF32, pg8::SchedPlain, true, ACT, ws + WT_FFN2 + (size_t)(fi_) * D * F * 2, F, F, D, ({Y, D}), S_.btoff = 0); \
        else { GF f = mkgf(ACT, F, F, ffn_w2 + (size_t)(fi_) * F * D, D, EP_F32, Y, D); ph_gemm(mkctx(ldsb), f, D / 64, 1); } GRID_BAR(); \
        LN_PHASE(i_, 1, X, last_); } while (0)
#define MOE(i_, mi_, last_) do { int* cnt = ctl + CW_CNT + 16 * (mi_); \
        ph_route(mkctx(ldsb), X, MOD + (size_t)(i_) * 2 * 6 * D, moe_wr + (size_t)(mi_) * D * NE, moe_br + (size_t)(mi_) * NE, cnt, tok_e, tok_g, tok_pos, XS); GRID_BAR(); \
        if (FAST_GEMM) { pg8::Gemm g{(const pg8::bf16_t*)XS, (const pg8::bf16_t*)(ws + WT_MOE13 + (size_t)(mi_) * NE * 2 * F * D * 2), D, D}; pg8::SchedMoE<true> S_; S_.setup(cnt, 2 * F, G_, (int)blockIdx.x); \
            pg8::EpiSwiglu E_{ACT, F}; pg8::gemm_phase<pg8::EpiSwiglu, pg8::SchedMoE<true>, true, true>(ldsb, g, S_, E_); } \
        else { GF f = mkgf(XS, D, D, moe_w13 + (size_t)(mi_) * NE * D * 2 * F, 2 * F, EP_SWIGLU, ACT, F); f.gather = tok_e; f.cnt = cnt; f.bz = (size_t)D * 2 * F; ph_gemm(mkctx(ldsb), f, F / 32, NE); } GRID_BAR(); \
        if (FAST_GEMM) { pg8::Gemm g{(const pg8::bf16_t*)ACT, (const pg8::bf16_t*)(ws + WT_MOE2 + (size_t)(mi_) * NE * D * F * 2), F, F}; pg8::SchedMoE<false> S_; S_.setup(cnt, D, G_, (int)blockIdx.x); \
            pg8::EpiBf16<0> E_{YS, D, 0, (size_t)0, 1.f, nullptr, nullptr, 0}; pg8::gemm_phase<pg8::EpiBf16<0>, pg8::SchedMoE<false>, true, true>(ldsb, g, S_, E_); } \
        else { GF f = mkgf(ACT, F, F, moe_w2 + (size_t)(mi_) * NE * F * D, D, EP_BF16, YS, D); f.cnt = cnt; f.a_compact = 1; f.bz = (size_t)F * D; ph_gemm(mkctx(ldsb), f, D / 64, NE); } GRID_BAR(); \
        { LnArgs a; a.xin = X; a.y = nullptr; a.xout = (last_) ? args.out : X; a.hout = (last_) ? nullptr : Hb; \
          a.gate = MOD + (size_t)(i_) * 2 * 6 * D + 5 * D; a.gamma = ln_g + (size_t)((i_) * 2 + 1) * D; a.beta = ln_b + (size_t)((i_) * 2 + 1) * D; a.nsh = MOD + (size_t)((i_) + 1) * 2 * 6 * D; \
          a.ys = YS; a.tok_e = tok_e; a.tok_pos = tok_pos; a.tok_g = tok_g; a.cnt = cnt; ph_ln(mkctx(ldsb), a); } if (!(last_)) GRID_BAR(); } while (0)

    GMLP(0, 0, x);
    FFN(0, 0, false);
    if (FAST_GEMM) FASTG(pg8::EpiBf16<0>, pg8::SchedPlain, true, Hb, ws + WT_FOX_IN, D, D, 3 * D, ({Qb, D, D, (size_t)M * D, QSCALE, nullptr, nullptr, 0}), S_.btoff = 0);
    else { GF f = mkgf(Hb, D, D, fox_w_in, 3 * D + H, EP_QKV, Qb, D); ph_gemm(mkctx(ldsb), f, 3 * D / 64, 1); }
    ph_flogit(mkctx(ldsb), X, MOD + (size_t)1 * 2 * 6 * D, fox_w_in, fox_b_f, LF); GRID_BAR();
    ph_fscan(mkctx(ldsb), LF, CUM); GRID_BAR();
#ifndef FAST_ATTN
#define FAST_ATTN 1
#endif
    if (FAST_ATTN) { static_assert(attn_body::ATTN_LDS_BYTES <= 131072, "attention LDS");
        const attn_body::AttnTensors AT{(const attn_body::bf16*)Qb, (const attn_body::bf16*)Kb, (const attn_body::bf16*)Vb, (attn_body::bf16*)AO, CUM};
        const attn_body::StaticOrder SA(G_, (int)blockIdx.x); attn_body::attn_phase<attn_body::StaticOrder>((char*)lds_raw, AT, SA); }
    else ph_attn(mkctx(ldsb), Qb, Kb, Vb, CUM, AO);
    GRID_BAR();
    if (FAST_GEMM) FASTG(pg8::EpiF32, pg8::SchedPlain, true, AO, ws + WT_FOX_OUT, D, D, D, ({Y, D}), S_.btoff = 0);
    else { GF f = mkgf(AO, D, D, fox_w_out, D, EP_F32, Y, D); ph_gemm(mkctx(ldsb), f, D / 64, 1); } GRID_BAR();
    LN_PHASE(1, 0, X, false);
    MOE(1, 0, false);
    if (FAST_GEMM) FASTG(pg8::EpiBf16<0>, pg8::SchedPlain, true, Hb, ws + WT_POOL_IN, D, D, D, ({PZ, D, 0, (size_t)0, 1.f, nullptr, nullptr, 0}), S_.btoff = 0);
    else { GF f = mkgf(Hb, D, D, pool_w_in, D, EP_BF16, PZ, D); ph_gemm(mkctx(ldsb), f, D / 64, 1); } GRID_BAR();
    ph_pool(mkctx(ldsb), PZ, PP); GRID_BAR();
    if (FAST_GEMM) FASTG(pg8::EpiBf16<0>, pg8::SchedPoolGrp, true, PP, ws + WT_POOL_GRP, D, 256, D, ({PG, D, 0, (size_t)0, 1.f, pool_scale, nullptr, 0}), (void)0);
    else { GF f = mkgf(PP, D, 256, pool_w_grp, 256, EP_BF16, PG, D); f.colscale = pool_scale; f.grouped = 1; ph_gemm(mkctx(ldsb), f, D / 64, 1); } GRID_BAR();
    if (FAST_GEMM) FASTG(pg8::EpiF32, pg8::SchedPlain, true, PG, ws + WT_POOL_OUT, D, D, D, ({Y, D}), S_.btoff = 0);
    else { GF f = mkgf(PG, D, D, pool_w_out, D, EP_F32, Y, D); ph_gemm(mkctx(ldsb), f, D / 64, 1); } GRID_BAR();
    LN_PHASE(2, 0, X, false);
    FFN(2, 1, false);
    GMLP(3, 1, X);
    MOE(3, 1, true);
}

extern "C" void kernel_launch(void* const* d_in, const int* in_sizes, int n_in, void* d_out, int out_size, void* d_ws, size_t ws_size, hipStream_t stream) {
    static int grid = 0;
    if (grid == 0) {
        if (n_in != 25 || ws_size < WS_END || out_size != M * D) { fprintf(stderr, "kernel_launch: unexpected shapes (n_in %d, ws %zu, out %d)\n", n_in, ws_size, out_size); grid = -1; return; }
        int dev = 0, cus = 0, per_cu = 0;
        if (hipGetDevice(&dev) != hipSuccess || hipDeviceGetAttribute(&cus, hipDeviceAttributeMultiprocessorCount, dev) != hipSuccess) { grid = -1; return; }
        if (hipFuncSetAttribute((const void*)mega_fwd, hipFuncAttributeMaxDynamicSharedMemorySize, LDS_BYTES) != hipSuccess) { fprintf(stderr, "kernel_launch: hipFuncSetAttribute failed\n"); grid = -1; return; }
        if (hipOccupancyMaxActiveBlocksPerMultiprocessor(&per_cu, (const void*)mega_fwd, NWAVES * 64, LDS_BYTES) != hipSuccess || per_cu < 1) { fprintf(stderr, "kernel_launch: occupancy query says %d\n", per_cu); }
        (void)hipGetLastError();
        grid = cus;
    }
    if (grid < 0) return;
    if (hipMemsetAsync((char*)d_ws + WS_CTL, 0, CTL_ZERO_BYTES, stream) != hipSuccess) return;
    Args a; memset(&a, 0, sizeof a);
    for (int i = 0; i < 25; ++i) a.in[i] = (const float*)d_in[i];
    a.out = (float*)d_out; a.ws = (unsigned char*)d_ws;
    hipLaunchKernelGGL(mega_fwd, dim3(grid), dim3(NWAVES * 64), LDS_BYTES, stream, a);
}
```

```cpp
#include <hip/hip_runtime.h>
#include <hip/hip_bf16.h>
#include <cmath>
#include <cstdio>
#include <cstdint>
#include <cstring>

typedef unsigned short bf16;
typedef short bf16x8 __attribute__((ext_vector_type(8)));
typedef float f32x4 __attribute__((ext_vector_type(4)));
typedef unsigned u32x4 __attribute__((ext_vector_type(4)));
typedef unsigned u32x2 __attribute__((ext_vector_type(2)));

constexpr int D = 1024, NB = 2, S = 8192, M = NB * S, DEPTH = 4;
constexpr int GW = 2048, GMG = 8, CH = 128, F = 3584, NE = 8, H = 16, HD = 64;
constexpr float LN_EPS = 1e-5f;
constexpr float DN_ALPHA = 1.6817928305074290860622509524664f;
constexpr float LOG2E = 1.4426950408889634f;
constexpr float QSCALE = 0.125f * LOG2E;

constexpr size_t MiB = 1u << 20;
constexpr size_t WS_CTL = 0;
constexpr size_t WS_MOD = 1 * MiB;
constexpr size_t WS_X = 2 * MiB;
constexpr size_t WS_Y = 66 * MiB;
constexpr size_t WS_H = 130 * MiB;
constexpr size_t WS_Z = 162 * MiB;
constexpr size_t WS_VLN = 290 * MiB;
constexpr size_t WS_G = 354 * MiB;
constexpr size_t WS_ACT = 418 * MiB;
constexpr size_t WS_Q = 658 * MiB;
constexpr size_t WS_AO = 754 * MiB;
constexpr size_t WS_LF = 786 * MiB;
constexpr size_t WS_CUM = 787 * MiB;
constexpr size_t WS_PZ = 788 * MiB;
constexpr size_t WS_PP = 820 * MiB;
constexpr size_t WS_PG = 852 * MiB;
constexpr size_t WS_YS = 884 * MiB;
constexpr size_t WS_RT = 952 * MiB;
constexpr size_t WS_VST = 956 * MiB;
constexpr size_t WS_WT = 960 * MiB;
constexpr size_t WT_GM_IN = WS_WT, WT_GM_OUT = WS_WT + 16 * MiB, WT_FOX_IN = WS_WT + 24 * MiB, WT_FOX_OUT = WS_WT + 30 * MiB, WT_POOL_IN = WS_WT + 32 * MiB, WT_POOL_OUT = WS_WT + 34 * MiB,
                 WT_POOL_GRP = WS_WT + 36 * MiB, WT_GMS = WS_WT + 36 * MiB + 512 * 1024  , WT_FFN13 = WS_WT + 37 * MiB, WT_FFN2 = WS_WT + 65 * MiB, WT_MOE13 = WS_WT + 79 * MiB, WT_MOE2 = WS_WT + 303 * MiB;
constexpr size_t WS_XS = 1376 * MiB;
constexpr size_t WS_END = 1632 * MiB;
constexpr int CW_CNT = 64;

__device__ __forceinline__ unsigned f2bf(float f) { unsigned u = __builtin_bit_cast(unsigned, f); return (u + 0x7fffu + ((u >> 16) & 1u)) >> 16; }
__device__ __forceinline__ float bf2f(unsigned short u) { return __builtin_bit_cast(float, (unsigned)u << 16); }
__device__ __forceinline__ unsigned pk2(float lo, float hi) { return f2bf(lo) | (f2bf(hi) << 16); }
__device__ __forceinline__ float wave_sum(float v) {
#pragma unroll
    for (int o = 1; o < 64; o <<= 1) v += __shfl_xor(v, o);
    return v;
}
__device__ __forceinline__ float wave_max(float v) {
#pragma unroll
    for (int o = 1; o < 64; o <<= 1) v = fmaxf(v, __shfl_xor(v, o));
    return v;
}
__device__ __forceinline__ float silu_f(float v) { return v / (1.f + __expf(-v)); }
__device__ __forceinline__ float gelu_f(float v) { return 0.5f * v * (1.f + erff(v * 0.70710678118654752f)); }


namespace pg8 {
#define PG8_LAS __attribute__((address_space(3)))
typedef unsigned short bf16_t;
typedef short bf16x8 __attribute__((ext_vector_type(8)));
typedef float f32x4 __attribute__((ext_vector_type(4)));
typedef unsigned u32x4 __attribute__((ext_vector_type(4)));
constexpr int M_ROWS = 16384;
constexpr int BM = 256, BK = 64, HALF = 128, HTB = HALF * BK * 2  , STAGE_BYTES = 8 * HTB, NXCD = 8, WGM = 8;

__host__ __device__ __forceinline__ int lds_byte(int r, int c) { const int st = (r >> 4) * 2 + (c >> 5), rr = r & 15, cc = c & 31, ob = rr * 64 + cc * 2; return st * 1024 + (ob ^ (((ob >> 9) & 1) << 5)); }
__host__ __device__ __forceinline__ void stage_rc(int b, int& R, int& C) { const int st = b / 1024, sb = b % 1024, swz = sb ^ (((sb >> 9) & 1) << 5); R = (st >> 1) * 16 + swz / 64; C = (st & 1) * 32 + (swz % 64) / 2; }
__host__ __device__ __forceinline__ int perm32(int rho) { const int n = rho >> 4, i = rho & 15; return 8 * (i >> 2) + 4 * n + (i & 3); }

struct Unit { int pm, pn, pa, bt, acol; };
struct Gemm { const bf16_t* A; const bf16_t* Bt; int lda, K; };

struct StaticOrder {
    int nM, nN, nwg, G, c;
    __host__ __device__ void init(int M, int N, int G_, int c_) { nM = M / BM; nN = N / BM; nwg = nM * nN; G = G_; c = c_; }
    __host__ __device__ bool next(int i, Unit& u) const {
        const long L = (long)i * G + c; if (L >= nwg) return false;
        int wgid = (int)L; { const int q = nwg / NXCD, r = nwg % NXCD, xcd = wgid % NXCD, off = wgid / NXCD; wgid = (xcd < r ? xcd * (q + 1) : r * (q + 1) + (xcd - r) * q) + off; }
        const int nig = WGM * nN, gid = wgid / nig, fm = gid * WGM, gsz = (nM - fm) < WGM ? (nM - fm) : WGM;
        u.pm = fm + ((wgid % nig) % gsz); u.pn = (wgid % nig) / gsz; u.pa = u.pm; u.bt = u.pn; u.acol = 0; return true;
    }
    __device__ __forceinline__ void a_ready(const Unit&) const {}
    __device__ __forceinline__ void done(const Unit&) const {}
};

__device__ __forceinline__ unsigned cvt_pk_bf16(float lo, float hi) { unsigned r; asm volatile("v_cvt_pk_bf16_f32 %0, %1, %2" : "=v"(r) : "v"(lo), "v"(hi)); return r; }
typedef float f32x2 __attribute__((ext_vector_type(2)));
__device__ __forceinline__ f32x2 gelu_pk(f32x2 v) {
    const f32x2 av = __builtin_elementwise_abs(v), d = av * 0.2316418882f + 1.0f;
    f32x2 t; t.x = __builtin_amdgcn_rcpf(d.x); t.y = __builtin_amdgcn_rcpf(d.y);
    f32x2 q = t * 0.5307027145f + (-0.7265760135f); q = q * t + 0.7107068705f; q = q * t + (-0.142248368f); q = q * t + 0.127414796f; q = q * t;
    const f32x2 s = (v * v) * (-0.72134752044f);
    f32x2 e; e.x = __builtin_amdgcn_exp2f(s.x); e.y = __builtin_amdgcn_exp2f(s.y);
    const f32x2 m = v * (q * e), r = v - m;
    f32x2 o; o.x = v.x < 0.f ? m.x : r.x; o.y = v.y < 0.f ? m.y : r.y; return o;
}
__device__ __forceinline__ float silu_fast(float v) { return v * __builtin_amdgcn_rcpf(1.0f + __builtin_amdgcn_exp2f(v * -1.4426950408889634f)); }

struct EpiF32 {
    static constexpr bool PERM = false, AFTER_DRAIN = false;
    float* C; int ldc;
    __device__ __forceinline__ void operator()(const f32x4 (&acc)[2][2][4][2], const Unit& u, int wr, int wc, int fr, int fq) const {
        const int row0 = u.pm * BM + wr * 64 + fr, col0 = u.pn * BM + wc * 32 + 4 * fq;
#pragma unroll
        for (int ai = 0; ai < 2; ++ai)
#pragma unroll
            for (int m = 0; m < 4; ++m) { float* rowp = C + (size_t)(row0 + ai * HALF + m * 16) * ldc + col0;
#pragma unroll
                for (int bj = 0; bj < 2; ++bj)
#pragma unroll
                    for (int n = 0; n < 2; ++n) *(f32x4*)(rowp + bj * HALF + n * 16) = acc[ai][bj][m][n]; }
    }
};
template <int ACT> struct EpiBf16 {
    static constexpr bool PERM = true, AFTER_DRAIN = false;
    bf16_t* O; int ldc; int split_cols; size_t split_stride; float scale0; const float* colscale; float* vst; int vst_pn0;
    __device__ __forceinline__ void operator()(const f32x4 (&acc)[2][2][4][2], const Unit& u, int wr, int wc, int fr, int fq) const {
        const int row0 = u.pm * BM + wr * 64 + fr; int colt = u.pn * BM; bf16_t* base = O;
        float sc = 1.f; if (split_cols) { const int t = colt / split_cols; base += (size_t)t * split_stride; colt -= t * split_cols; if (t == 0) sc = scale0; }
        const int col0 = colt + wc * 32 + 8 * fq, ccol0 = u.pn * BM + wc * 32 + 8 * fq;
        f32x4 cs[2][2];
#pragma unroll
        for (int bj = 0; bj < 2; ++bj)
#pragma unroll
            for (int n = 0; n < 2; ++n) cs[bj][n] = colscale ? *(const f32x4*)(colscale + ccol0 + bj * HALF + 4 * n) * sc : (f32x4){sc, sc, sc, sc};
        const bool do_st = (ACT == 1) && vst != nullptr && u.pn >= vst_pn0;
#pragma unroll
        for (int ai = 0; ai < 2; ++ai)
#pragma unroll
            for (int m = 0; m < 4; ++m) { bf16_t* rowp = base + (size_t)(row0 + ai * HALF + m * 16) * ldc + col0; float s1 = 0.f, s2 = 0.f;
#pragma unroll
                for (int bj = 0; bj < 2; ++bj) { f32x4 v0 = acc[ai][bj][m][0], v1 = acc[ai][bj][m][1];
                    if (ACT == 1) { f32x2 a = gelu_pk((f32x2){v0[0], v0[1]}), b = gelu_pk((f32x2){v0[2], v0[3]}), c = gelu_pk((f32x2){v1[0], v1[1]}), d = gelu_pk((f32x2){v1[2], v1[3]});
                        v0 = (f32x4){a.x, a.y, b.x, b.y}; v1 = (f32x4){c.x, c.y, d.x, d.y};
                        s1 += ((v0[0] + v0[1]) + (v0[2] + v0[3])) + ((v1[0] + v1[1]) + (v1[2] + v1[3]));
                        s2 += ((v0[0] * v0[0] + v0[1] * v0[1]) + (v0[2] * v0[2] + v0[3] * v0[3])) + ((v1[0] * v1[0] + v1[1] * v1[1]) + (v1[2] * v1[2] + v1[3] * v1[3])); }
                    v0 = v0 * cs[bj][0]; v1 = v1 * cs[bj][1]; u32x4 w; w.x = cvt_pk_bf16(v0[0], v0[1]); w.y = cvt_pk_bf16(v0[2], v0[3]); w.z = cvt_pk_bf16(v1[0], v1[1]); w.w = cvt_pk_bf16(v1[2], v1[3]);
                    *(u32x4*)(rowp + bj * HALF) = w; }
                if (ACT == 1) { if (do_st) { s1 += __shfl_xor(s1, 16); s1 += __shfl_xor(s1, 32); s2 += __shfl_xor(s2, 16); s2 += __shfl_xor(s2, 32);
                    if (fq == 0) { f32x2 st; st.x = s1; st.y = s2; *(f32x2*)(vst + ((size_t)(row0 + ai * HALF + m * 16) * 32 + (u.pn - vst_pn0) * 4 + wc) * 2) = st; } } } }
    }
};
struct EpiSwiglu {
    static constexpr bool PERM = true, AFTER_DRAIN = false;
    bf16_t* O; int ldo;
    __device__ __forceinline__ void operator()(const f32x4 (&acc)[2][2][4][2], const Unit& u, int wr, int wc, int fr, int fq) const {
        const int row0 = u.pm * BM + wr * 64 + fr, col0 = u.pn * HALF + wc * 32 + 8 * fq;
#pragma unroll
        for (int ai = 0; ai < 2; ++ai)
#pragma unroll
            for (int m = 0; m < 4; ++m) { bf16_t* rowp = O + (size_t)(row0 + ai * HALF + m * 16) * ldo + col0;
                const f32x4 a0 = acc[ai][0][m][0], a1 = acc[ai][0][m][1], b0 = acc[ai][1][m][0], b1 = acc[ai][1][m][1];
                u32x4 w; w.x = cvt_pk_bf16(silu_fast(a0[0]) * b0[0], silu_fast(a0[1]) * b0[1]); w.y = cvt_pk_bf16(silu_fast(a0[2]) * b0[2], silu_fast(a0[3]) * b0[3]);
                w.z = cvt_pk_bf16(silu_fast(a1[0]) * b1[0], silu_fast(a1[1]) * b1[1]); w.w = cvt_pk_bf16(silu_fast(a1[2]) * b1[2], silu_fast(a1[3]) * b1[3]);
                *(u32x4*)rowp = w; }
    }
};
struct SchedPlain : StaticOrder { int btoff;
    __device__ __forceinline__ bool next(int i, Unit& u) const { if (!StaticOrder::next(i, u)) return false; u.bt += btoff; return true; } };
struct SchedPoolGrp : StaticOrder {
    __device__ __forceinline__ bool next(int i, Unit& u) const { if (!StaticOrder::next(i, u)) return false; u.acol = 256 * u.pn; return true; } };

template <class Epi, class Sched, bool ALIGN_EPI = false, bool SP2 = false>
__device__ __forceinline__ void gemm_phase(PG8_LAS unsigned char* lds, const Gemm g, const Sched& S, const Epi& E) {
    int tid_ = threadIdx.x; asm volatile("" : "+v"(tid_));
    const int tid = tid_, wid = __builtin_amdgcn_readfirstlane(tid >> 6), lane = tid & 63, wr = wid >> 2, wc = wid & 3, fr = lane & 15, fq = lane >> 4;
    const int K = g.K, nt = K / BK, lda = g.lda;
    unsigned voffA[2], voffB[2];
#pragma unroll
    for (int i = 0; i < 2; ++i) { int R, C; stage_rc(tid * 16 + i * 8192, R, C); const int Rb = Epi::PERM ? ((R & ~31) + perm32(R & 31)) : R;
        voffA[i] = (unsigned)(R * lda + C) * 2u; voffB[i] = (unsigned)(Rb * K + C) * 2u; }
    const size_t kstep = (size_t)(BK * 2);
    const size_t hstepA = (size_t)HALF * lda * 2, hstepB = (size_t)HALF * K * 2;
    const size_t tstepB = 2 * hstepB;
    const unsigned ldsw = (unsigned)wid * 1024u;
    const int aoff = lds_byte(wr * 64 + fr, fq * 8), boff = lds_byte(wc * 32 + fr, fq * 8);
#define PG8_ABASE(u) ((const char*)g.A + ((size_t)(u).pa * BM * lda + (size_t)(u).acol) * 2)
#define PG8_BBASE(u) ((const char*)g.Bt + (size_t)(u).bt * tstepB)
#define PG8_SA(b, h) (((b) * 2 + (h)) * HTB)
#define PG8_SB(b, h) ((4 + (b) * 2 + (h)) * HTB)
#define PG8_STAGE(bufoff, gbase, voff) do { _Pragma("unroll") for (int _i = 0; _i < 2; ++_i) \
        __builtin_amdgcn_global_load_lds((const unsigned*)((const char*)(gbase) + (voff)[_i]), (PG8_LAS unsigned*)(lds + (bufoff) + ldsw + _i * 8192), 16, 0, 0); } while (0)
#define PG8_LDA(dst, b, h) do { _Pragma("unroll") for (int m = 0; m < 4; ++m) _Pragma("unroll") for (int k = 0; k < 2; ++k) dst[m][k] = *(const PG8_LAS bf16x8*)(lds + PG8_SA(b, h) + aoff + m * 2048 + k * 1024); } while (0)
#define PG8_LDB(dst, b, h) do { _Pragma("unroll") for (int n = 0; n < 2; ++n) _Pragma("unroll") for (int k = 0; k < 2; ++k) dst[n][k] = *(const PG8_LAS bf16x8*)(lds + PG8_SB(b, h) + boff + n * 2048 + k * 1024); } while (0)
#define PG8_MMA(ai, bj, At, Bt) do { __builtin_amdgcn_s_setprio(1); _Pragma("unroll") for (int m = 0; m < 4; ++m) _Pragma("unroll") for (int n = 0; n < 2; ++n) _Pragma("unroll") for (int k = 0; k < 2; ++k) \
        acc[ai][bj][m][n] = __builtin_amdgcn_mfma_f32_16x16x32_bf16(Bt[n][k], At[m][k], acc[ai][bj][m][n], 0, 0, 0); __builtin_amdgcn_s_setprio(0); } while (0)
#define PG8_WAIT_V(n) asm volatile("s_waitcnt vmcnt(" #n ")" ::: "memory")
#define PG8_WAIT_L(n) asm volatile("s_waitcnt lgkmcnt(" #n ")" ::: "memory")
#define PG8_BAR __builtin_amdgcn_s_barrier()
#define PG8_SCHED __builtin_amdgcn_sched_barrier(0)
    Unit cur, nxt; int ui = 0;
    if (!S.next(0, cur)) return;
    f32x4 acc[2][2][4][2];
#pragma unroll
    for (int a = 0; a < 2; ++a)
#pragma unroll
        for (int b = 0; b < 2; ++b)
#pragma unroll
            for (int m = 0; m < 4; ++m)
#pragma unroll
                for (int n = 0; n < 2; ++n) acc[a][b][m][n] = (f32x4){0.f, 0.f, 0.f, 0.f};
    bf16x8 At[4][2], B0[2][2], B1[2][2];
    const char* cA = PG8_ABASE(cur); const char* cB = PG8_BBASE(cur);
    S.a_ready(cur);
    if constexpr (SP2) {
        PG8_STAGE(PG8_SB(0, 0), cB, voffB); PG8_STAGE(PG8_SB(0, 1), cB + hstepB, voffB); PG8_STAGE(PG8_SA(0, 0), cA, voffA); PG8_STAGE(PG8_SA(0, 1), cA + hstepA, voffA);
        if (wr == 1) PG8_BAR;
        PG8_WAIT_V(2); PG8_BAR;
        PG8_STAGE(PG8_SB(1, 0), cB + kstep, voffB); PG8_STAGE(PG8_SA(1, 0), cA + kstep, voffA); PG8_STAGE(PG8_SB(1, 1), cB + hstepB + kstep, voffB);
        PG8_WAIT_V(6); PG8_BAR;
    } else {
        PG8_STAGE(PG8_SB(0, 0), cB, voffB); PG8_STAGE(PG8_SA(0, 0), cA, voffA); PG8_STAGE(PG8_SB(0, 1), cB + hstepB, voffB); PG8_STAGE(PG8_SA(0, 1), cA + hstepA, voffA);
        if (wr == 1) PG8_BAR;
        PG8_WAIT_V(4); PG8_BAR;
        PG8_STAGE(PG8_SB(1, 0), cB + kstep, voffB); PG8_STAGE(PG8_SA(1, 0), cA + kstep, voffA); PG8_STAGE(PG8_SB(1, 1), cB + hstepB + kstep, voffB);
        PG8_WAIT_V(6); PG8_BAR;
    }
    for (;;) {
        const bool has_next = S.next(ui + 1, nxt);
        const char* nA = has_next ? PG8_ABASE(nxt) : cA; const char* nB = has_next ? PG8_BBASE(nxt) : cB;
        for (int t = 0; t < nt; t += 2) {
            const bool last = (t == nt - 2);
            const char* a1 = cA + (size_t)(t + 1) * kstep;
            const char* a2 = last ? nA : cA + (size_t)(t + 2) * kstep; const char* b2 = last ? nB : cB + (size_t)(t + 2) * kstep;
            const char* a3 = a2 + kstep; const char* b3 = b2 + kstep;
            if (last && has_next) S.a_ready(nxt);
            if constexpr (SP2) {
            PG8_LDB(B0, 0, 0); PG8_LDB(B1, 0, 1); PG8_SCHED; PG8_LDA(At, 0, 0); PG8_STAGE(PG8_SA(1, 1), a1 + hstepA, voffA);
            PG8_WAIT_V(8); PG8_WAIT_L(0); PG8_BAR; PG8_MMA(0, 0, At, B0); PG8_MMA(0, 1, At, B1); PG8_BAR; PG8_SCHED;
            PG8_LDA(At, 0, 1); PG8_STAGE(PG8_SB(0, 0), b2, voffB); PG8_STAGE(PG8_SB(0, 1), b2 + hstepB, voffB); PG8_STAGE(PG8_SA(0, 0), a2, voffA);
            PG8_WAIT_V(8); PG8_WAIT_L(0); PG8_BAR; PG8_MMA(1, 0, At, B0); PG8_MMA(1, 1, At, B1); PG8_BAR; PG8_SCHED;
            PG8_LDB(B0, 1, 0); PG8_LDB(B1, 1, 1); PG8_SCHED; PG8_LDA(At, 1, 0); PG8_STAGE(PG8_SA(0, 1), a2 + hstepA, voffA);
            PG8_WAIT_V(8); PG8_WAIT_L(0); PG8_BAR; PG8_MMA(0, 0, At, B0); PG8_MMA(0, 1, At, B1); PG8_BAR; PG8_SCHED;
            PG8_LDA(At, 1, 1); PG8_STAGE(PG8_SB(1, 0), b3, voffB); PG8_STAGE(PG8_SB(1, 1), b3 + hstepB, voffB); PG8_STAGE(PG8_SA(1, 0), a3, voffA);
            PG8_WAIT_V(8); PG8_WAIT_L(0); PG8_BAR; PG8_MMA(1, 0, At, B0); PG8_MMA(1, 1, At, B1); PG8_BAR; PG8_SCHED;
            } else {
            PG8_LDB(B0, 0, 0); PG8_SCHED; PG8_LDA(At, 0, 0); PG8_STAGE(PG8_SA(1, 1), a1 + hstepA, voffA);
            PG8_WAIT_L(8); PG8_BAR; PG8_WAIT_L(0); PG8_MMA(0, 0, At, B0); PG8_BAR; PG8_SCHED;
            PG8_LDB(B1, 0, 1); PG8_STAGE(PG8_SB(0, 0), b2, voffB);
            PG8_BAR; PG8_WAIT_L(0); PG8_MMA(0, 1, At, B1); PG8_BAR;
            PG8_LDA(At, 0, 1); PG8_STAGE(PG8_SA(0, 0), a2, voffA);
            PG8_BAR; PG8_WAIT_L(0); PG8_MMA(1, 0, At, B0); PG8_BAR; PG8_SCHED;
            PG8_STAGE(PG8_SB(0, 1), b2 + hstepB, voffB);
            PG8_WAIT_V(6); PG8_BAR; PG8_MMA(1, 1, At, B1); PG8_BAR;
            PG8_LDB(B0, 1, 0); PG8_SCHED; PG8_LDA(At, 1, 0); PG8_STAGE(PG8_SA(0, 1), a2 + hstepA, voffA);
            PG8_WAIT_L(8); PG8_BAR; PG8_WAIT_L(0); PG8_MMA(0, 0, At, B0); PG8_BAR; PG8_SCHED;
            PG8_LDB(B1, 1, 1); PG8_STAGE(PG8_SB(1, 0), b3, voffB);
            PG8_BAR; PG8_WAIT_L(0); PG8_MMA(0, 1, At, B1); PG8_BAR;
            PG8_LDA(At, 1, 1); PG8_STAGE(PG8_SA(1, 0), a3, voffA);
            PG8_BAR; PG8_WAIT_L(0); PG8_MMA(1, 0, At, B0); PG8_BAR; PG8_SCHED;
            PG8_STAGE(PG8_SB(1, 1), b3 + hstepB, voffB);
            PG8_WAIT_V(6); PG8_BAR; PG8_MMA(1, 1, At, B1); PG8_BAR;
            }
        }
        if constexpr (ALIGN_EPI) { if (wr == 0) PG8_BAR; }
        if constexpr (!Epi::AFTER_DRAIN) { E(acc, cur, wr, wc, fr, fq); S.done(cur); }
        if (!has_next) break;
#pragma unroll
        for (int a = 0; a < 2; ++a)
#pragma unroll
            for (int b = 0; b < 2; ++b)
#pragma unroll
                for (int m = 0; m < 4; ++m)
#pragma unroll
                    for (int n = 0; n < 2; ++n) acc[a][b][m][n] = (f32x4){0.f, 0.f, 0.f, 0.f};
        cur = nxt; cA = nA; cB = nB; ++ui;
        if constexpr (ALIGN_EPI) { if (wr == 1) PG8_BAR; }
    }
    PG8_WAIT_V(0);
    if constexpr (!ALIGN_EPI) { if (wr == 0) PG8_BAR; }
    PG8_BAR;
    if constexpr (Epi::AFTER_DRAIN) { E.fused(acc, cur, wr, wc, fr, fq, lds, wid, lane); S.done(cur); }
#undef PG8_SA
#undef PG8_ABASE
#undef PG8_BBASE
#undef PG8_SB
#undef PG8_STAGE
#undef PG8_LDA
#undef PG8_LDB
#undef PG8_MMA
#undef PG8_WAIT_V
#undef PG8_WAIT_L
#undef PG8_BAR
#undef PG8_SCHED
}
template <bool A_FIXED> struct SchedMoE : StaticOrder {
    int tb1, tb2, tb3, tb4, tb5, tb6, tb7, nn;
    __device__ __forceinline__ void setup(const int* cnt, int N, int G_, int c_) {
        const int t0 = (cnt[0] + 255) >> 8, t1 = (cnt[1] + 255) >> 8, t2 = (cnt[2] + 255) >> 8, t3 = (cnt[3] + 255) >> 8, t4 = (cnt[4] + 255) >> 8, t5 = (cnt[5] + 255) >> 8, t6 = (cnt[6] + 255) >> 8, t7 = (cnt[7] + 255) >> 8;
        tb1 = t0; tb2 = tb1 + t1; tb3 = tb2 + t2; tb4 = tb3 + t3; tb5 = tb4 + t4; tb6 = tb5 + t5; tb7 = tb6 + t6; nn = N / BM;
        init((tb7 + t7) * BM, N, G_, c_);
    }
    __device__ __forceinline__ bool next(int i, Unit& u) const {
        if (!StaticOrder::next(i, u)) return false;
        const int pm = u.pm;
        const int e = (pm >= tb1) + (pm >= tb2) + (pm >= tb3) + (pm >= tb4) + (pm >= tb5) + (pm >= tb6) + (pm >= tb7);
        const int tb = (e == 0) ? 0 : (e == 1) ? tb1 : (e == 2) ? tb2 : (e == 3) ? tb3 : (e == 4) ? tb4 : (e == 5) ? tb5 : (e == 6) ? tb6 : tb7;
        u.bt = e * nn + u.pn; u.pa = A_FIXED ? e * (M_ROWS / BM) + (pm - tb) : pm; return true;
    }
};
}

namespace attn_body {
using bf16=__hip_bfloat16;
using bf16x8=__attribute__((ext_vector_type(8)))short;
using s16x4=__attribute__((ext_vector_type(4)))short;
using f32x16=__attribute__((ext_vector_type(16)))float;
using u32x4=__attribute__((ext_vector_type(4)))unsigned;
using f32x4_t=__attribute__((ext_vector_type(4)))float;
constexpr int BATCH=2,NHEAD=16,SEQ=8192,D=64,DM=NHEAD*D;
constexpr int NW=8,QBLK=32,QB=QBLK*NW,KVBLK=64,NQB=SEQ/QB;
constexpr int ATTN_PITCH=DM, ATTN_UNIT_ROWS=QB;
__device__ __forceinline__ int crow(int r,int hi){return (r&3)+8*(r>>2)+4*hi;}
#define SBAR() __builtin_amdgcn_sched_barrier(0)
__device__ __forceinline__ void cmask(f32x16&p0,f32x16&p1,int jb,int qrel,int hi){
  const float NEG=-INFINITY; int kb=64*jb+4*hi;
  #pragma unroll
  for(int r=0;r<16;++r){int kv=kb+(r&3)+8*(r>>2); if(kv>qrel)p0[r]=NEG; if(kv+32>qrel)p1[r]=NEG;}
}

constexpr int NSLOT=3, SLOTB=8192;
constexpr int LDS_K=0, LDS_V=NSLOT*SLOTB, LDS_WS=2*NSLOT*SLOTB, LDS_OST=LDS_WS+NW*64*4, LDS_NCK=LDS_OST+NW*4096, LDS_BYTES=LDS_NCK+SEQ*4;
constexpr float C2=0.125f*1.4426950408889634f;
__device__ __forceinline__ void glds16(const void*gsrc,unsigned lds_dst){unsigned keep;
  asm volatile("s_mov_b32 %0, m0\n\ts_mov_b32 m0, %2\n\ts_nop 0\n\tglobal_load_lds_dwordx4 %1, off\n\ts_mov_b32 m0, %0":"=&s"(keep):"v"(gsrc),"s"(lds_dst):"memory");}
__device__ __forceinline__ float max3f(float a,float b,float c){float r;asm("v_max3_f32 %0, %1, %2, %3":"=v"(r):"v"(a),"v"(b),"v"(c));return r;}
__device__ __forceinline__ float max2f(float a,float b){float r;asm("v_max_f32_e32 %0, %1, %2":"=v"(r):"v"(a),"v"(b));return r;}
__device__ __forceinline__ float fadd_s(float a,float b){float r;asm("v_add_f32_e32 %0, %1, %2":"=v"(r):"v"(a),"v"(b));return r;}
__device__ __forceinline__ float fsub_s(float a,float b){float r;asm("v_sub_f32_e32 %0, %1, %2":"=v"(r):"v"(a),"v"(b));return r;}
typedef float f32x2_t __attribute__((ext_vector_type(2))); typedef __bf16 bf16x2_t __attribute__((ext_vector_type(2)));
__device__ __forceinline__ unsigned cvtpk_s(float lo,float hi){f32x2_t v={lo,hi};bf16x2_t b=__builtin_convertvector(v,bf16x2_t);return __builtin_bit_cast(unsigned,b);}
#define WAIT_BAR(N) asm volatile("s_waitcnt vmcnt(" #N ") lgkmcnt(0)\n\ts_barrier":::"memory")

__device__ __forceinline__ void qkt(f32x16&p0,f32x16&p1,const char*Kslot,const bf16x8*qr,int r32,int hi){
  const char*kb=Kslot+hi*1024+r32*16;
  #pragma unroll
  for(int d0=0;d0<4;++d0){
    const bf16x8 b0=*reinterpret_cast<const bf16x8*>(kb+d0*2048);
    const bf16x8 b1=*reinterpret_cast<const bf16x8*>(kb+d0*2048+512);
    p0=__builtin_amdgcn_mfma_f32_32x32x16_bf16(b0,qr[d0],p0,0,0,0);p1=__builtin_amdgcn_mfma_f32_32x32x16_bf16(b1,qr[d0],p1,0,0,0);}
}
typedef __attribute__((address_space(3))) const char* lds_cptr;
typedef short v4i16_t __attribute__((ext_vector_type(4)));
__device__ __forceinline__ void kload8(bf16x8*kf,lds_cptr kp){
  kf[0]=*(const __attribute__((address_space(3))) bf16x8*)(kp);      kf[1]=*(const __attribute__((address_space(3))) bf16x8*)(kp+512);
  kf[2]=*(const __attribute__((address_space(3))) bf16x8*)(kp+2048); kf[3]=*(const __attribute__((address_space(3))) bf16x8*)(kp+2560);
  kf[4]=*(const __attribute__((address_space(3))) bf16x8*)(kp+4096); kf[5]=*(const __attribute__((address_space(3))) bf16x8*)(kp+4608);
  kf[6]=*(const __attribute__((address_space(3))) bf16x8*)(kp+6144); kf[7]=*(const __attribute__((address_space(3))) bf16x8*)(kp+6656);
}
__device__ __forceinline__ void kload2(bf16x8*kf,lds_cptr kp,int j){ kf[2*j]=*(const __attribute__((address_space(3))) bf16x8*)(kp+j*2048); kf[2*j+1]=*(const __attribute__((address_space(3))) bf16x8*)(kp+j*2048+512); }
__device__ __forceinline__ s16x4 vtr(lds_cptr p){ return __builtin_bit_cast(s16x4,__builtin_amdgcn_ds_read_tr16_b64_v4i16((__attribute__((address_space(3))) v4i16_t*)p)); }
__device__ __forceinline__ float rowmax(const f32x16&p0,const f32x16&p1){
  float a=max3f(p0[0],p0[1],p1[0]),b=max3f(p0[2],p0[3],p1[1]);a=max3f(a,p1[2],p1[3]);
  #pragma unroll
  for(int r=4;r<16;r+=4){a=max3f(a,p0[r],p0[r+1]);b=max3f(b,p0[r+2],p0[r+3]);a=max3f(a,p1[r],p1[r+1]);b=max3f(b,p1[r+2],p1[r+3]);}
  const float m=max2f(a,b);
  auto rr=__builtin_amdgcn_permlane32_swap(__float_as_uint(m),__float_as_uint(m),false,false);
  return max2f(__uint_as_float(rr[0]),__uint_as_float(rr[1]));
}
__device__ __forceinline__ void pv(f32x16*o,int vb,bf16x8 pa0,bf16x8 pa1,bf16x8 pa2,bf16x8 pa3){
  #pragma unroll
  for(int d0=0;d0<2;++d0){s16x4 lo[4],hi[4];
    #pragma unroll
    for(int ks=0;ks<4;++ks){
      asm volatile("ds_read_b64_tr_b16 %0,%1 offset:%c2":"=&v"(lo[ks]):"v"(vb),"i"(d0*4096+ks*1024):"memory");
      asm volatile("ds_read_b64_tr_b16 %0,%1 offset:%c2":"=&v"(hi[ks]):"v"(vb),"i"(d0*4096+ks*1024+512):"memory");}
    asm volatile("s_waitcnt lgkmcnt(0)":::"memory");SBAR();
    #define PK(k) (bf16x8){lo[k][0],lo[k][1],lo[k][2],lo[k][3],hi[k][0],hi[k][1],hi[k][2],hi[k][3]}
    o[d0]=__builtin_amdgcn_mfma_f32_32x32x16_bf16(pa0,PK(0),o[d0],0,0,0);
    o[d0]=__builtin_amdgcn_mfma_f32_32x32x16_bf16(pa1,PK(1),o[d0],0,0,0);
    o[d0]=__builtin_amdgcn_mfma_f32_32x32x16_bf16(pa2,PK(2),o[d0],0,0,0);
    o[d0]=__builtin_amdgcn_mfma_f32_32x32x16_bf16(pa3,PK(3),o[d0],0,0,0);
    #undef PK
  }
}

#ifndef ATTN_STORE16
#define ATTN_STORE16(p,v) (*(u32x4*)(p)=(v))
#endif
template<int THRL> __device__ __forceinline__ void attn_unit(int b,int h,int qb,const bf16*Q,const bf16*__restrict__ K,const bf16*__restrict__ V,bf16*O,const float*__restrict__ NCK,char*shm){
  const int tid=threadIdx.x,lane=tid&63,r32=lane&31,hi=lane>>5; const int wid=__builtin_amdgcn_readfirstlane(tid>>6);
  const long rowbase=(long)b*SEQ; const int q0=qb*QB;
  const bf16*Qw=Q+(rowbase+q0+wid*QBLK)*DM+h*D;
  const bf16*Kh=K+rowbase*DM+h*D,*Vh=V+rowbase*DM+h*D;
  const unsigned lds0=(unsigned)(uintptr_t)shm;
  float*wsf=(float*)(shm+LDS_WS)+wid*64;
  const bf16*ksrc=Kh+(long)lane*DM+wid*8;
  const bf16*vsrc=Vh+(long)(16*(wid&3)+(lane>>2))*DM+(wid>>2)*32+(lane&3)*8;
  const unsigned kdst=lds0+LDS_K+wid*1024, vdst=lds0+LDS_V+wid*1024;
  #define DMA_K(t,slot) glds16(ksrc+(long)(t)*KVBLK*DM,(unsigned)__builtin_amdgcn_readfirstlane(kdst+(slot)))
  #define DMA_V(t,slot) glds16(vsrc+(long)(t)*KVBLK*DM,(unsigned)__builtin_amdgcn_readfirstlane(vdst+(slot)))
  const int vb0=(int)(lds0+LDS_V)+((lane>>4)&1)*32+(lane&3)*8+(4*hi+((lane&15)>>2))*64;
  const char*Kbase=shm+LDS_K; bf16x8 kf[8];
  const lds_cptr shm3=(lds_cptr)shm; const lds_cptr kp0=shm3+LDS_K+hi*1024+r32*16; const lds_cptr vp0=shm3+LDS_V+((lane>>4)&1)*32+(lane&3)*8+(4*hi+((lane&15)>>2))*64;
  const int NT=(q0+QB)/KVBLK;
  { const float*nsrc=NCK+(long)(b*NHEAD+h)*SEQ+lane*4;
    #pragma unroll
    for(int i=0;i<4;++i) glds16(nsrc+(i*8+wid)*256,(unsigned)__builtin_amdgcn_readfirstlane(lds0+LDS_NCK+(i*8+wid)*1024)); }
  DMA_K(0,0);DMA_V(0,0);DMA_K(1,SLOTB);
  bf16x8 qr[4];
  #pragma unroll
  for(int d0=0;d0<4;++d0)qr[d0]=*reinterpret_cast<const bf16x8*>(&Qw[(long)r32*DM+d0*16+hi*8]);
  float mhat=0.f,l_reg=0.f,cq2=0.f,base=0.f;f32x16 o[2];o[0]=f32x16{};o[1]=f32x16{};
  const int qrel=wid*QBLK+r32;
  #define CMASK(P0,P1,t) do{int jb_=(t)-(NT-4); if(jb_>=0)cmask(P0,P1,jb_,qrel,hi);}while(0)
  bool resc=false;
  #define START(P0,P1) do{ const float rm=rowmax(P0,P1); resc=false; \
    { const float dl=rm; mhat=fadd_s(mhat,dl); \
      _Pragma("unroll") for(int r=0;r<16;++r){P0[r]=fsub_s(P0[r],dl);P1[r]=fsub_s(P1[r],dl);} \
      base=cq2-mhat; } \
    _Pragma("unroll") for(int r=0;r<16;++r)P0[r]=__builtin_amdgcn_exp2f(P0[r]); }while(0)
  #define RESC() do{ if(resc){ asm volatile("s_waitcnt lgkmcnt(0)":::"memory"); \
      _Pragma("unroll") for(int d_=0;d_<2;++d_) _Pragma("unroll") for(int r=0;r<16;++r)o[d_][r]*=wsf[crow(r,hi)]; } }while(0)
  f32x16 pA0,pA1,pB0,pB1;
  int sl_prev=0,sl_cur=0,sl_next=SLOTB;
  #define ROT() do{sl_prev=sl_cur;sl_cur=sl_next;sl_next=(sl_next==(NSLOT-1)*SLOTB)?0:sl_next+SLOTB;}while(0)
  DMA_K(2,2*SLOTB);
  WAIT_BAR(3);
  const lds_cptr nckp=(lds_cptr)shm+LDS_NCK+hi*16;
  #define CINIT(C0,C1,t) do{ const lds_cptr np_=nckp+(t)*256; \
    _Pragma("unroll") for(int g_=0;g_<4;++g_){ const f32x4_t a_=*(const __attribute__((address_space(3))) f32x4_t*)(np_+g_*32); const f32x4_t b_=*(const __attribute__((address_space(3))) f32x4_t*)(np_+g_*32+128); \
      C0[4*g_]=a_[0]+base;C0[4*g_+1]=a_[1]+base;C0[4*g_+2]=a_[2]+base;C0[4*g_+3]=a_[3]+base; C1[4*g_]=b_[0]+base;C1[4*g_+1]=b_[1]+base;C1[4*g_+2]=b_[2]+base;C1[4*g_+3]=b_[3]+base; } }while(0)
  cq2=-*(const __attribute__((address_space(3))) float*)((lds_cptr)shm+LDS_NCK+(q0+wid*QBLK+r32)*4); base=cq2;
  CINIT(pA0,pA1,0);
  qkt(pA0,pA1,Kbase,qr,r32,hi);asm volatile("s_nop 15\n\ts_nop 7":"+v"(pA0),"+v"(pA1));CMASK(pA0,pA1,0);
  START(pA0,pA1);
  _Pragma("unroll") for(int r=0;r<16;++r)pA1[r]=__builtin_amdgcn_exp2f(pA1[r]);
  WAIT_BAR(0);
  DMA_K(3,0);DMA_V(1,SLOTB);
  ROT();
  kload8(kf,kp0+sl_cur);
  WAIT_BAR(2);
  s16x4 vlo[8],vhi[8]; u32x4 pw0,pw1,pw2,pw3;
  #define PKW(P,B) cvtpk_s(P[B],P[B+1])
  #define PAF(k) __builtin_bit_cast(bf16x8,pw##k)
  #define VFR(i) (bf16x8){vlo[i][0],vlo[i][1],vlo[i][2],vlo[i][3],vhi[i][0],vhi[i][1],vhi[i][2],vhi[i][3]}
  #define PIN(x) asm volatile("":"+v"(x))
  #define MX3(a,b,c) __builtin_fmaxf(__builtin_fmaxf((a),(b)),(c))
  #define GAPA(MF,A0,A1,A2,A3,W0,W1,PW) do{ MF; sacc+=A0; sacc+=A1; sacc+=A2; sacc+=A3; PIN(sacc); W0; W1; PIN(PW); SBAR(); }while(0)
  #define EX(v) __builtin_amdgcn_exp2f(v)
  #define GAPB(MF,X,B) do{ MF; X[B]=EX(X[B]); X[B+1]=EX(X[B+1]); X[B+2]=EX(X[B+2]); X[B+3]=EX(X[B+3]); PIN(X); SBAR(); }while(0)
  #define VRD(i) do{ vlo[i]=vtr(vp_+(((i)>>2)*4096+((i)&3)*1024)); vhi[i]=vtr(vp_+(((i)>>2)*4096+((i)&3)*1024+512)); }while(0)
  #define KRD(G,j) do{ if(G){ kload2(kf,kp0+sl_next,j); SBAR(); } }while(0)
  #define STEP(C0,C1,P0,P1,t,GK,GV,GL) do{ CINIT(C0,C1,t); SBAR(); \
    const lds_cptr vp_=vp0+sl_prev; \
    VRD(0); SBAR(); float sacc=(P0[0]+P0[1]); \
    GAPA(C0=__builtin_amdgcn_mfma_f32_32x32x16_bf16(kf[0],qr[0],C0,0,0,0), P0[2],P0[3],P0[4],P0[5],     pw0[0]=PKW(P0,0), pw0[1]=PKW(P0,2), pw0); \
    VRD(4); SBAR(); GAPA(C1=__builtin_amdgcn_mfma_f32_32x32x16_bf16(kf[1],qr[0],C1,0,0,0), P0[6],P0[7],P0[8],P0[9],     pw0[2]=PKW(P0,4), pw0[3]=PKW(P0,6), pw0); \
    VRD(1); SBAR(); GAPA(C0=__builtin_amdgcn_mfma_f32_32x32x16_bf16(kf[2],qr[1],C0,0,0,0),   P0[10],P0[11],P0[12],P0[13], pw1[0]=PKW(P0,8), pw1[1]=PKW(P0,10), pw1); \
    VRD(5); SBAR(); GAPA(C1=__builtin_amdgcn_mfma_f32_32x32x16_bf16(kf[3],qr[1],C1,0,0,0),   P0[14],P0[15],P1[0],P1[1],   pw1[2]=PKW(P0,12),pw1[3]=PKW(P0,14), pw1); \
    VRD(2); SBAR(); GAPA(C0=__builtin_amdgcn_mfma_f32_32x32x16_bf16(kf[4],qr[2],C0,0,0,0),   P1[2],P1[3],P1[4],P1[5],     pw2[0]=PKW(P1,0), pw2[1]=PKW(P1,2), pw2); \
    VRD(6); SBAR(); GAPA(C1=__builtin_amdgcn_mfma_f32_32x32x16_bf16(kf[5],qr[2],C1,0,0,0),   P1[6],P1[7],P1[8],P1[9],     pw2[2]=PKW(P1,4), pw2[3]=PKW(P1,6), pw2); \
    VRD(3); SBAR(); GAPA(C0=__builtin_amdgcn_mfma_f32_32x32x16_bf16(kf[6],qr[3],C0,0,0,0),   P1[10],P1[11],P1[12],P1[13], pw3[0]=PKW(P1,8), pw3[1]=PKW(P1,10), pw3); \
    VRD(7); SBAR(); GAPA(C1=__builtin_amdgcn_mfma_f32_32x32x16_bf16(kf[7],qr[3],C1,0,0,0),   P1[14],P1[15],0.f,0.f,       pw3[2]=PKW(P1,12),pw3[3]=PKW(P1,14), pw3); \
    l_reg+=sacc; \
    if(GK){DMA_K((t)+3,sl_cur);} if(GV){DMA_V((t)+1,sl_next);} \
    CMASK(C0,C1,t); \
    { float a=MX3(C0[0],C0[1],C1[0]),b=MX3(C0[2],C0[3],C1[1]); a=MX3(a,C1[2],C1[3]); \
      _Pragma("unroll") for(int r=4;r<16;r+=4){a=MX3(a,C0[r],C0[r+1]);b=MX3(b,C0[r+2],C0[r+3]);a=MX3(a,C1[r],C1[r+1]);b=MX3(b,C1[r+2],C1[r+3]);} \
      float rm=__builtin_fmaxf(a,b); { auto rr=__builtin_amdgcn_permlane32_swap(__float_as_uint(rm),__float_as_uint(rm),false,false); rm=__builtin_fmaxf(__uint_as_float(rr[0]),__uint_as_float(rr[1])); } \
      resc=false; \
      if(__builtin_expect(__any(rm>(float)THRL),0)){ const float dl=__builtin_fmaxf(rm,0.f); mhat+=dl; \
        _Pragma("unroll") for(int r=0;r<16;++r){C0[r]-=dl;C1[r]-=dl;} \
        base=cq2-mhat; \
        const float f=__builtin_amdgcn_exp2f(-dl); l_reg*=f; if(hi==0)wsf[r32]=f; resc=true; } } \
    SBAR(); \
    GAPB(o[0]=__builtin_amdgcn_mfma_f32_32x32x16_bf16(PAF(0),VFR(0),o[0],0,0,0), C0,0); \
    GAPB(o[1]=__builtin_amdgcn_mfma_f32_32x32x16_bf16(PAF(0),VFR(4),o[1],0,0,0), C0,4); \
    KRD(GL,0); GAPB(o[0]=__builtin_amdgcn_mfma_f32_32x32x16_bf16(PAF(1),VFR(1),o[0],0,0,0), C0,8); \
    KRD(GL,1); GAPB(o[1]=__builtin_amdgcn_mfma_f32_32x32x16_bf16(PAF(1),VFR(5),o[1],0,0,0), C0,12); \
    KRD(GL,2); GAPB(o[0]=__builtin_amdgcn_mfma_f32_32x32x16_bf16(PAF(2),VFR(2),o[0],0,0,0), C1,0); \
    KRD(GL,3); GAPB(o[1]=__builtin_amdgcn_mfma_f32_32x32x16_bf16(PAF(2),VFR(6),o[1],0,0,0), C1,4); \
    GAPB(o[0]=__builtin_amdgcn_mfma_f32_32x32x16_bf16(PAF(3),VFR(3),o[0],0,0,0), C1,8); \
    GAPB(o[1]=__builtin_amdgcn_mfma_f32_32x32x16_bf16(PAF(3),VFR(7),o[1],0,0,0), C1,12); \
    }while(0)
  int t=1;
  #undef CMASK
  #define CMASK(P0,P1,t) do{}while(0)
  for(;t+5<NT;t+=2){
    STEP(pB0,pB1,pA0,pA1,t,true,true,true);     WAIT_BAR(2); RESC(); ROT();
    STEP(pA0,pA1,pB0,pB1,t+1,true,true,true);   WAIT_BAR(2); RESC(); ROT();
  }
  #undef CMASK
  #define CMASK(P0,P1,t) do{int jb_=(t)-(NT-4); if(jb_>=0)cmask(P0,P1,jb_,qrel,hi);}while(0)
  #define ENDW(tt) do{ if((tt)+3<NT){WAIT_BAR(2);} else if((tt)+2<NT){WAIT_BAR(1);} else {WAIT_BAR(0);} }while(0)
  for(;t+1<NT;t+=2){
    STEP(pB0,pB1,pA0,pA1,t,(t+3<NT),(t+1<NT),(t+1<NT));       ENDW(t);   RESC(); ROT();
    STEP(pA0,pA1,pB0,pB1,t+1,(t+4<NT),(t+2<NT),(t+2<NT));     ENDW(t+1); RESC(); ROT();
  }
  STEP(pB0,pB1,pA0,pA1,NT-1,false,false,false); RESC();
  { float sacc=pB0[0]+pB0[1]; _Pragma("unroll") for(int r=2;r<16;++r)sacc+=pB0[r]; _Pragma("unroll") for(int r=0;r<16;++r)sacc+=pB1[r]; l_reg+=sacc;
    pw0=(u32x4){PKW(pB0,0),PKW(pB0,2),PKW(pB0,4),PKW(pB0,6)};pw1=(u32x4){PKW(pB0,8),PKW(pB0,10),PKW(pB0,12),PKW(pB0,14)};pw2=(u32x4){PKW(pB1,0),PKW(pB1,2),PKW(pB1,4),PKW(pB1,6)};pw3=(u32x4){PKW(pB1,8),PKW(pB1,10),PKW(pB1,12),PKW(pB1,14)};
    SBAR(); pv(o,vb0+sl_cur,PAF(0),PAF(1),PAF(2),PAF(3)); }
  #undef PKW
  #undef PAF
  #undef VFR
  #undef PIN
  #undef MX3
  #undef GAPA
  #undef GAPB
  #undef EX
  #undef VRD
  #undef KRD
  #undef STEP
  #undef CINIT
  #undef ENDW
  {auto rr=__builtin_amdgcn_permlane32_swap(__float_as_uint(l_reg),__float_as_uint(l_reg),false,false);l_reg=__uint_as_float(rr[0])+__uint_as_float(rr[1]);}
  if(hi==0)wsf[32+r32]=l_reg;asm volatile("s_waitcnt lgkmcnt(0)":::"memory");
  float rli[16];
  #pragma unroll
  for(int r=0;r<16;++r)rli[r]=__builtin_amdgcn_rcpf(wsf[32+crow(r,hi)]);
  bf16*Ow=O+(rowbase+q0+wid*QBLK)*DM+h*D;
  { bf16*stg=(bf16*)(shm+LDS_OST)+wid*2048;
    #pragma unroll
    for(int r=0;r<16;++r){const int orow=crow(r,hi);
      #pragma unroll
      for(int d0=0;d0<2;++d0)stg[orow*64+d0*32+r32]=__float2bfloat16(o[d0][r]*rli[r]);}
    asm volatile("s_waitcnt lgkmcnt(0)":::"memory");
    #pragma unroll
    for(int i=0;i<4;++i){const int row=i*8+(lane>>3),ch=lane&7; const u32x4 v=*(const u32x4*)(stg+row*64+ch*8); ATTN_STORE16(Ow+(long)row*DM+ch*8,v);} }
  asm volatile("s_waitcnt lgkmcnt(0)\n\ts_barrier":::"memory");
  #undef DMA_K
  #undef DMA_V
  #undef CMASK
  #undef START
  #undef RESC
  #undef ROT
}
constexpr int ATTN_LDS_BYTES=LDS_BYTES;
struct AttnTensors { const bf16* Q; const bf16* K; const bf16* V; bf16* O; const float* NCK; };
struct AttnUnit { int bh; int qb; };
struct StaticOrder {
  int vcu;
  __device__ __forceinline__ explicit StaticOrder(int grid,int block):vcu(grid==256?(block%8)*(grid/8)+block/8:block),grid_(grid){}
  int grid_;
  __device__ __forceinline__ bool next(int i,AttnUnit&u)const{
    if(grid_!=256){ const int L=i*grid_+vcu; if(L>=BATCH*NHEAD*NQB)return false; const int j=L/(BATCH*NHEAD); u.bh=L%(BATCH*NHEAD); u.qb=(j&1)?NQB-1-(j>>1):(j>>1); return true; }
    if(i>=4)return false; const int s=vcu&7; u.bh=vcu>>3; u.qb=(i==0)?s:(i==1)?15-s:(i==2)?16+s:31-s; return true; }
  __device__ __forceinline__ void a_ready(const AttnUnit&)const{}
  __device__ __forceinline__ void done(const AttnUnit&)const{}
};
template<class Sched,int THRL=8> __device__ __forceinline__ void attn_phase(char*lds,const AttnTensors&T,const Sched&S){
  AttnUnit u;
  for(int i=0;S.next(i,u);++i){ S.a_ready(u); attn_unit<THRL>(u.bh/NHEAD,u.bh%NHEAD,u.qb,T.Q,T.K,T.V,T.O,T.NCK,lds); S.done(u); }
}
#undef SBAR
#undef WAIT_BAR
}

#define GAS __attribute__((address_space(1)))
#define LAS __attribute__((address_space(3)))
typedef GAS unsigned gu32;
#define RLX_AGENT __ATOMIC_RELAXED, __HIP_MEMORY_SCOPE_AGENT
constexpr int NWAVES = 8;
constexpr int CW_BAR = 4096;
constexpr size_t CTL_ZERO_BYTES = 64 * 1024;
constexpr int LDS_BYTES = 147456;
constexpr int MISC_OFF = 131072 + 320;

#define XB_TMO      128
#define XB_XCNT(j)  (256  + 64 * (j))
#define XB_XSUB(j)  (1280 + 64 * (j))
#define XB_XGEN(j)  (2304 + 64 * (j))
#define XB_TOP      3328
#define XB_TOPGEN   3392
#define XCD_BAR_WORDS 3456
#define XB_SPIN_CAP (1u << 21)

__device__ __forceinline__ unsigned xb_ld(unsigned* p)              { return __hip_atomic_load(p, __ATOMIC_RELAXED, __HIP_MEMORY_SCOPE_AGENT); }
__device__ __forceinline__ unsigned xb_add(unsigned* p, unsigned v) { return __hip_atomic_fetch_add(p, v, __ATOMIC_RELAXED, __HIP_MEMORY_SCOPE_AGENT); }
__device__ __forceinline__ unsigned xb_xcc_id() { return (unsigned)__builtin_amdgcn_s_getreg((3 << 11) | 20) & 0xFu; }
#define XB_SPIN(cond, bar) do { unsigned _sp = 0; while (cond) { __builtin_amdgcn_s_sleep(1); \
    if ((++_sp & 255u) == 0u) { if (xb_ld(&(bar)[XB_TMO])) break; if (_sp > XB_SPIN_CAP) { atomicAdd(&(bar)[XB_TMO], 1u); break; } } } } while (0)

struct XcdBarrier {
    unsigned* bar; unsigned x;
    volatile LAS unsigned* st;
};

__device__ __forceinline__ XcdBarrier xcd_barrier_post(unsigned* bar, volatile LAS unsigned* st) {
    XcdBarrier b; b.bar = bar; b.x = xb_xcc_id(); b.st = st;
    if (threadIdx.x == 0) (void)xb_add(&bar[XB_XCNT(b.x)], 1u);
    return b;
}
__device__ __forceinline__ void xcd_barrier_complete(unsigned* bar, unsigned x, unsigned& nloc, unsigned& nx) {
    const unsigned G = gridDim.x * gridDim.y * gridDim.z;
    unsigned sum, cnt, mine, sp = 0u;
    for (;;) {
        sum = 0u; cnt = 0u; mine = 0u;
#pragma unroll
        for (unsigned j = 0; j < 16; ++j) { const unsigned c = xb_ld(&bar[XB_XCNT(j)]); sum += c; cnt += (c > 0u) ? 1u : 0u; mine = (j == x) ? c : mine; }
        if (sum == G) break;
        __builtin_amdgcn_s_sleep(1);
        if ((++sp & 255u) == 0u) { if (xb_ld(&bar[XB_TMO])) break; if (sp > XB_SPIN_CAP) { atomicAdd(&bar[XB_TMO], 1u); break; } }
    }
    nloc = mine > 0u ? mine : 1u; nx = cnt > 0u ? cnt : 1u;
}

__device__ __forceinline__ void xcd_barrier(const XcdBarrier& b) {
    asm volatile("s_waitcnt vmcnt(0)" ::: "memory");
    __syncthreads();
    if (threadIdx.x == 0) {
        unsigned* bar = b.bar;
        __builtin_amdgcn_s_waitcnt(0);
        unsigned nloc = b.st[0], nx = b.st[1];
        if (nloc == 0u) { xcd_barrier_complete(bar, b.x, nloc, nx); b.st[0] = nloc; b.st[1] = nx; }
        const unsigned old = xb_add(&bar[XB_XSUB(b.x)], 1u);
        const unsigned gen = old / nloc;
        if (old + 1u == (gen + 1u) * nloc) {
            __builtin_amdgcn_fence(__ATOMIC_RELEASE, "agent");
            asm volatile("s_waitcnt vmcnt(0)" ::: "memory");
            const unsigned og = xb_add(&bar[XB_TOP], 1u);
            const unsigned tg = og / nx;
            if (og + 1u == (tg + 1u) * nx) xb_add(&bar[XB_TOPGEN], 1u);
            else XB_SPIN(xb_ld(&bar[XB_TOPGEN]) == tg, bar);
            __builtin_amdgcn_fence(__ATOMIC_ACQUIRE, "agent");
            xb_add(&bar[XB_XGEN(b.x)], 1u);
            asm volatile("s_waitcnt vmcnt(0)" ::: "memory");
        } else {
            XB_SPIN(xb_ld(&bar[XB_XGEN(b.x)]) == gen, bar);
            __builtin_amdgcn_fence(__ATOMIC_ACQUIRE, "agent");
            asm volatile("s_waitcnt vmcnt(0)" ::: "memory");
        }
    }
    __syncthreads();
}


struct Args { const float* in[25]; float* out; unsigned char* ws; };
static_assert(sizeof(Args) == 27 * 8, "Args has no padding");

struct Ctx { int gw, NGW, lane, wave, tid; LAS unsigned char* lds; };
__device__ __forceinline__ Ctx mkctx(LAS unsigned char* lds) {
    int t = threadIdx.x; asm volatile("" : "+v"(t));
    Ctx C; C.tid = t; C.lane = t & 63; C.wave = __builtin_amdgcn_readfirstlane(t >> 6); C.gw = blockIdx.x * NWAVES + C.wave; C.NGW = gridDim.x * NWAVES; C.lds = lds; return C;
}

__device__ __forceinline__ void ph_mod(const Ctx& C, const float* __restrict__ c, const float* __restrict__ mod_w, const float* __restrict__ mod_b, float* __restrict__ MOD) {
    LAS float* red = (LAS float*)C.lds;
    for (int it = blockIdx.x; it < DEPTH * 6 * D / 64; it += gridDim.x) {
        const int idx = it * 64 + C.lane, l = idx / (6 * D), m = idx % (6 * D);
        const float* w = mod_w + (size_t)l * D * 6 * D + m;
        float a0 = 0.f, a1 = 0.f;
        const int d0 = C.wave * 128;
#pragma unroll 16
        for (int d = d0; d < d0 + 128; ++d) { const float wv = w[(size_t)d * 6 * D]; a0 += silu_f(c[d]) * wv; a1 += silu_f(c[D + d]) * wv; }
        red[(C.wave * 2 + 0) * 64 + C.lane] = a0; red[(C.wave * 2 + 1) * 64 + C.lane] = a1;
        __syncthreads();
        if (C.wave < 2) {
            float s = 0.f;
#pragma unroll
            for (int w8 = 0; w8 < 8; ++w8) s += red[(w8 * 2 + C.wave) * 64 + C.lane];
            MOD[((size_t)l * 2 + C.wave) * 6 * D + m] = s + mod_b[idx];
        }
        __syncthreads();
    }
}

__device__ __forceinline__ void ph_modulate(const Ctx& C, const float* __restrict__ x, const float* __restrict__ MODl, bf16* __restrict__ Hout) {
    for (int row = C.gw; row < M; row += C.NGW) {
        const int lane = C.lane, b = row / S;
        const float* sh = MODl + (size_t)b * 6 * D; const float* sc = sh + D;
#pragma unroll
        for (int i = 0; i < 4; ++i) {
            const int col = lane * 4 + 256 * i;
            const f32x4 xv = *(const f32x4*)(x + (size_t)row * D + col), s1 = *(const f32x4*)(sc + col), s0 = *(const f32x4*)(sh + col);
            const f32x4 h = xv * (1.f + s1) + s0;
            u32x2 w; w.x = pk2(h[0], h[1]); w.y = pk2(h[2], h[3]);
            *(u32x2*)(Hout + (size_t)row * D + col) = w;
        }
    }
}

#define LDS_WAIT() asm volatile("s_waitcnt lgkmcnt(0)" ::: "memory")
__device__ __forceinline__ void cvt_item(const float* __restrict__ W, int ldw, int K, bf16* __restrict__ WT, int nblk, int item, int swiglu, LAS float* scr, int lane) {
    const int kb = item / nblk, nb = item % nblk, k0 = 64 * kb, n0 = 32 * nb;
    int drow0 = n0;
    if (swiglu) { const int j = (n0 < F) ? n0 : n0 - F; drow0 = 256 * (j >> 7) + (j & 127) + ((n0 < F) ? 0 : 128); }
#pragma unroll 8
    for (int i = 0; i < 32; ++i) { const int kk = 2 * i + (lane >> 5); scr[kk * 33 + (lane & 31)] = W[(size_t)(k0 + kk) * ldw + n0 + (lane & 31)]; }
    LDS_WAIT(); asm volatile("" ::: "memory");
    const int c = lane & 7;
#pragma unroll
    for (int j = 0; j < 4; ++j) { const int n = (lane >> 3) + 8 * j; const LAS float* sp = scr + (8 * c) * 33 + n;
        u32x4 o; o.x = pk2(sp[0 * 33], sp[1 * 33]); o.y = pk2(sp[2 * 33], sp[3 * 33]); o.z = pk2(sp[4 * 33], sp[5 * 33]); o.w = pk2(sp[6 * 33], sp[7 * 33]);
        *(u32x4*)(WT + (size_t)(drow0 + n) * K + k0 + 8 * c) = o; }
    LDS_WAIT(); asm volatile("" ::: "memory");
}
struct CvtPtrs { const float *gm_ws, *gm_in, *gm_out, *fox_in, *fox_out, *pool_in, *pool_out, *pool_grp, *ffn13, *ffn2, *moe13, *moe2; unsigned char* ws; };
__device__ __forceinline__ void ph_convert(const Ctx& C, const CvtPtrs& P) {
    LAS float* scr = (LAS float*)(C.lds + C.wave * 16384);
#define CVT_PER(K_, N_) (((K_) / 64) * ((N_) / 32))
    constexpr int NITEMS = 2 * CVT_PER(D, 4096) + 2 * CVT_PER(GW, D) + CVT_PER(D, 3 * D) + 3 * CVT_PER(D, D) + 4 * CVT_PER(256, 256) + 2 * CVT_PER(D, 2 * F) + 2 * CVT_PER(F, D) + 16 * CVT_PER(D, 2 * F) + 16 * CVT_PER(F, D);
#define CVT_CLASS(Wp, WTOFF, NMAT, K_, LDW, N_, SW) { constexpr int per = CVT_PER(K_, N_), tot = per * (NMAT); \
        if (r < tot) { const int mi = r / per, it2 = r % per; cvt_item((Wp) + (size_t)mi * (K_) * (LDW), LDW, K_, (bf16*)(P.ws + (WTOFF)) + (size_t)mi * (N_) * (K_), (N_) / 32, it2, SW, scr, C.lane); continue; } r -= tot; }
    for (int it = C.gw; it < NITEMS; it += C.NGW) {
        int r = it;
        CVT_CLASS(P.gm_in, WT_GM_IN, 2, D, 4096, 4096, 0)
        CVT_CLASS(P.gm_out, WT_GM_OUT, 2, GW, D, D, 0)
        CVT_CLASS(P.fox_in, WT_FOX_IN, 1, D, 3 * D + H, 3 * D, 0)
        CVT_CLASS(P.fox_out, WT_FOX_OUT, 1, D, D, D, 0)
        CVT_CLASS(P.pool_in, WT_POOL_IN, 1, D, D, D, 0)
        CVT_CLASS(P.pool_out, WT_POOL_OUT, 1, D, D, D, 0)
        CVT_CLASS(P.pool_grp, WT_POOL_GRP, 4, 256, 256, 256, 0)
        CVT_CLASS(P.ffn13, WT_FFN13, 2, D, 2 * F, 2 * F, 1)
        CVT_CLASS(P.ffn2, WT_FFN2, 2, F, D, D, 0)
        CVT_CLASS(P.moe13, WT_MOE13, 16, D, 2 * F, 2 * F, 1)
        CVT_CLASS(P.moe2, WT_MOE2, 16, F, D, D, 0)
    }
#undef CVT_CLASS
#undef CVT_PER
    { bf16* WSb = (bf16*)(P.ws + WT_GMS); const int nthr = C.NGW * 64, t0 = C.gw * 64 + C.lane;
      for (int i = t0; i < 2 * GMG * CH * CH / 8; i += nthr) { const int e0 = i * 8, t = (e0 >> 7) & 127, s0 = e0 & 127;
          const f32x4 a = *(const f32x4*)(P.gm_ws + e0), b = *(const f32x4*)(P.gm_ws + e0 + 4); u32x4 o;
          o.x = pk2(s0 + 0 <= t ? a[0] : 0.f, s0 + 1 <= t ? a[1] : 0.f); o.y = pk2(s0 + 2 <= t ? a[2] : 0.f, s0 + 3 <= t ? a[3] : 0.f);
          o.z = pk2(s0 + 4 <= t ? b[0] : 0.f, s0 + 5 <= t ? b[1] : 0.f); o.w = pk2(s0 + 6 <= t ? b[2] : 0.f, s0 + 7 <= t ? b[3] : 0.f);
          *(u32x4*)(WSb + e0) = o; } }
}

struct LnArgs {
    const float* xin; const float* y; float* xout; bf16* hout;
    const float* gate;
    const float* gamma; const float* beta;
    const float* nsh;
    const bf16* ys; const int* tok_e; const int* tok_pos; const float* tok_g; const int* cnt;
};
__device__ __forceinline__ void ph_ln(const Ctx& C, const LnArgs& a) {
    const int lane = C.lane;
    for (int rp = C.gw; rp < M / 2; rp += C.NGW) {
        const int b = (2 * rp) / S;
        const float* g = a.gate + (size_t)b * 6 * D;
        f32x4 v[2][4]; float s[2] = {0.f, 0.f};
        size_t r0[2] = {0, 0}, r1[2] = {0, 0}; float g0[2] = {0.f, 0.f}, g1[2] = {0.f, 0.f};
        if (a.ys) {
            int tb[NE]; int run = 0;
#pragma unroll
            for (int e = 0; e < NE; ++e) { tb[e] = run; run += ((a.cnt[e] + 255) >> 8) << 8; }
#pragma unroll
            for (int u = 0; u < 2; ++u) { const int row = 2 * rp + u; const int e0 = a.tok_e[row * 2], e1 = a.tok_e[row * 2 + 1]; int o0 = 0, o1 = 0;
#pragma unroll
                for (int e = 0; e < NE; ++e) { if (e == e0) o0 = tb[e]; if (e == e1) o1 = tb[e]; }
                r0[u] = (size_t)(o0 + a.tok_pos[row * 2]) * D; r1[u] = (size_t)(o1 + a.tok_pos[row * 2 + 1]) * D; g0[u] = a.tok_g[row * 2]; g1[u] = a.tok_g[row * 2 + 1]; }
        }
#pragma unroll
        for (int u = 0; u < 2; ++u)
#pragma unroll
            for (int i = 0; i < 4; ++i) {
                const int col = lane * 4 + 256 * i; const size_t row = (size_t)(2 * rp + u);
                const f32x4 xv = *(const f32x4*)(a.xin + row * D + col);
                f32x4 yv;
                if (a.ys) {
                    const u32x2 w0 = *(const u32x2*)(a.ys + r0[u] + col), w1 = *(const u32x2*)(a.ys + r1[u] + col);
                    yv[0] = g0[u] * bf2f(w0.x & 0xffff) + g1[u] * bf2f(w1.x & 0xffff); yv[1] = g0[u] * bf2f(w0.x >> 16) + g1[u] * bf2f(w1.x >> 16);
                    yv[2] = g0[u] * bf2f(w0.y & 0xffff) + g1[u] * bf2f(w1.y & 0xffff); yv[3] = g0[u] * bf2f(w0.y >> 16) + g1[u] * bf2f(w1.y >> 16);
                } else yv = *(const f32x4*)(a.y + row * D + col);
                const f32x4 gv = *(const f32x4*)(g + col);
                v[u][i] = DN_ALPHA * xv + (1.f + gv) * yv;
                s[u] += (v[u][i][0] + v[u][i][1]) + (v[u][i][2] + v[u][i][3]);
            }
        float mean[2], rstd[2];
#pragma unroll
        for (int u = 0; u < 2; ++u) mean[u] = wave_sum(s[u]) * (1.f / D);
#pragma unroll
        for (int u = 0; u < 2; ++u) { float s2 = 0.f;
#pragma unroll
            for (int i = 0; i < 4; ++i) { v[u][i] = v[u][i] - mean[u]; s2 += (v[u][i][0] * v[u][i][0] + v[u][i][1] * v[u][i][1]) + (v[u][i][2] * v[u][i][2] + v[u][i][3] * v[u][i][3]); }
            rstd[u] = 1.f / sqrtf(wave_sum(s2) * (1.f / D) + LN_EPS); }
#pragma unroll
        for (int i = 0; i < 4; ++i) {
            const int col = lane * 4 + 256 * i;
            const f32x4 gam = *(const f32x4*)(a.gamma + col), bet = *(const f32x4*)(a.beta + col);
            f32x4 sc1 = {0.f, 0.f, 0.f, 0.f}, sh1 = {0.f, 0.f, 0.f, 0.f};
            if (a.hout) { const float* sh = a.nsh + (size_t)b * 6 * D; sh1 = *(const f32x4*)(sh + col); sc1 = *(const f32x4*)(sh + D + col); }
#pragma unroll
            for (int u = 0; u < 2; ++u) { const size_t row = (size_t)(2 * rp + u);
                const f32x4 o = v[u][i] * rstd[u] * gam + bet;
                *(f32x4*)(a.xout + row * D + col) = o;
                if (a.hout) { const f32x4 h = o * (1.f + sc1) + sh1; u32x2 w; w.x = pk2(h[0], h[1]); w.y = pk2(h[2], h[3]); *(u32x2*)(a.hout + row * D + col) = w; } }
        }
    }
}

enum { EP_F32 = 0, EP_BF16 = 1, EP_GELU = 2, EP_SWIGLU = 3, EP_QKV = 4 };
struct GF {
    const bf16* A;
    const int* gather;
    const int* cnt;
    const float* B; size_t bz;
    void* out;
    const float* colscale;
    int lda, K, Mrows;
    int a_compact;
    int ldb, mode, ldo;
    int grouped;
};
__device__ __forceinline__ void ph_gemm(const Ctx& C, const GF& f, int ncg, int nz) {
    const int lane = C.lane, fr = lane & 15, fq = lane >> 4;
    const int nrg = f.Mrows / 16;
    const long total = (long)nrg * ncg * nz;
    for (long item = C.gw; item < total; item += C.NGW) {
        const int rg = (int)(item % nrg), cg = (int)((item / nrg) % ncg), z = (int)(item / ((long)nrg * ncg));
        int nrows = f.Mrows, obase = 0;
        if (f.cnt) { nrows = f.cnt[z]; for (int e = 0; e < z; ++e) obase += ((f.cnt[e] + 255) >> 8) << 8; }
        const int row0 = rg * 16;
        if (row0 >= nrows) continue;
        int r = row0 + fr; const bool rvalid = r < nrows; if (!rvalid) r = nrows - 1;
        size_t arow = (size_t)r;
        if (f.gather) arow = (size_t)z * M + r; else if (f.a_compact) arow = (size_t)(obase + r);
        const bf16* ap = f.A + arow * f.lda + fq * 8;
        const float* Bz = f.B + (size_t)z * f.bz;
        int col[4];
#pragma unroll
        for (int t = 0; t < 4; ++t) col[t] = (f.mode == EP_SWIGLU) ? ((t < 2) ? 32 * cg + 16 * t : F + 32 * cg + 16 * (t - 2)) : 64 * cg + 16 * t;
        const float* bp[4];
        if (f.grouped) { const int g = (64 * cg) >> 8; ap += g * 256; Bz += (size_t)g * 256 * 256;
#pragma unroll
            for (int t = 0; t < 4; ++t) bp[t] = Bz + (size_t)(fq * 8) * f.ldb + (col[t] - 256 * g) + fr;
        } else {
#pragma unroll
            for (int t = 0; t < 4; ++t) bp[t] = Bz + (size_t)(fq * 8) * f.ldb + col[t] + fr;
        }
        f32x4 acc[4];
#pragma unroll
        for (int t = 0; t < 4; ++t) acc[t] = (f32x4){0.f, 0.f, 0.f, 0.f};
        const int K = f.K; const size_t ldb = (size_t)f.ldb;
        for (int k0 = 0; k0 < K; k0 += 32) {
            const bf16x8 af = *(const bf16x8*)(ap + k0);
#pragma unroll
            for (int t = 0; t < 4; ++t) {
                bf16x8 bfr;
#pragma unroll
                for (int j = 0; j < 8; ++j) bfr[j] = (short)f2bf(bp[t][(size_t)(k0 + j) * ldb]);
                acc[t] = __builtin_amdgcn_mfma_f32_16x16x32_bf16(bfr, af, acc[t], 0, 0, 0);
            }
        }
        if (!rvalid) continue;
        r = row0 + fr;
        const size_t orow = (size_t)(f.cnt ? obase + r : r);
        if (f.mode == EP_SWIGLU) {
#pragma unroll
            for (int t = 0; t < 2; ++t) {
                float o[4];
#pragma unroll
                for (int i = 0; i < 4; ++i) o[i] = silu_f(acc[t][i]) * acc[t + 2][i];
                u32x2 w; w.x = pk2(o[0], o[1]); w.y = pk2(o[2], o[3]);
                *(u32x2*)((bf16*)f.out + orow * f.ldo + 32 * cg + 16 * t + 4 * fq) = w;
            }
            continue;
        }
#pragma unroll
        for (int t = 0; t < 4; ++t) {
            const int c = col[t] + 4 * fq;
            f32x4 v = acc[t];
            if (f.mode == EP_F32) { *(f32x4*)((float*)f.out + orow * f.ldo + c) = v; continue; }
            if (f.mode == EP_GELU) { v[0] = gelu_f(v[0]); v[1] = gelu_f(v[1]); v[2] = gelu_f(v[2]); v[3] = gelu_f(v[3]); }
            if (f.colscale) v = v * *(const f32x4*)(f.colscale + c);
            bf16* o = (bf16*)f.out; int cc = c;
            if (f.mode == EP_QKV) { const int which = c >> 10; cc = c & 1023; o += (size_t)which * M * D; if (which == 0) v = v * QSCALE; }
            u32x2 w; w.x = pk2(v[0], v[1]); w.y = pk2(v[2], v[3]);
            *(u32x2*)(o + orow * f.ldo + cc) = w;
        }
    }
}

__device__ __forceinline__ void ph_vln(const Ctx& C, const bf16* __restrict__ Z, const float* __restrict__ g, const float* __restrict__ bb, bf16* __restrict__ VLN) {
    for (int row = C.gw; row < M; row += C.NGW) {
        const int lane = C.lane;
        float v[32]; float s = 0.f;
#pragma unroll
        for (int i = 0; i < 4; ++i) {
            const u32x4 w = *(const u32x4*)(Z + (size_t)row * 4096 + GW + lane * 8 + 512 * i);
#pragma unroll
            for (int j = 0; j < 4; ++j) { v[i * 8 + 2 * j] = bf2f(w[j] & 0xffff); v[i * 8 + 2 * j + 1] = bf2f(w[j] >> 16); }
        }
#pragma unroll
        for (int i = 0; i < 32; ++i) s += v[i];
        const float mean = wave_sum(s) * (1.f / GW); float s2 = 0.f;
#pragma unroll
        for (int i = 0; i < 32; ++i) { v[i] -= mean; s2 += v[i] * v[i]; }
        const float rstd = 1.f / sqrtf(wave_sum(s2) * (1.f / GW) + LN_EPS);
#pragma unroll
        for (int i = 0; i < 4; ++i) {
            const int c0 = lane * 8 + 512 * i; u32x4 w;
#pragma unroll
            for (int j = 0; j < 4; ++j) w[j] = pk2(v[i * 8 + 2 * j] * rstd * g[c0 + 2 * j] + bb[c0 + 2 * j], v[i * 8 + 2 * j + 1] * rstd * g[c0 + 2 * j + 1] + bb[c0 + 2 * j + 1]);
            *(u32x4*)(VLN + (size_t)row * GW + c0) = w;
        }
    }
}
__device__ __forceinline__ void ph_mix(const Ctx& C, const bf16* __restrict__ Z, const bf16* __restrict__ VLN, const float* __restrict__ ws_, const float* __restrict__ bs, bf16* __restrict__ G) {
    LAS bf16* tile = (LAS bf16*)C.lds;
    const int c = C.tid & 255, th = C.tid >> 8;
    for (int it = blockIdx.x; it < (M / CH) * GMG; it += gridDim.x) {
        const int chunk = it / GMG, g = it % GMG;
        const size_t row0 = (size_t)chunk * CH;
        for (int s = th * 64; s < th * 64 + 64; ++s) tile[s * 256 + c] = VLN[(row0 + s) * GW + g * 256 + c];
        __syncthreads();
        const float* w = ws_ + (size_t)g * CH * CH;
        for (int t = th * 64; t < th * 64 + 64; ++t) {
            float acc = 0.f;
            for (int s = 0; s <= t; ++s) acc += w[t * CH + s] * bf2f(tile[s * 256 + c]);
            acc += bs[g * CH + t];
            const float u = bf2f(Z[(row0 + t) * 4096 + g * 256 + c]);
            G[(row0 + t) * GW + g * 256 + c] = (bf16)f2bf(u * acc);
        }
        __syncthreads();
    }
}

typedef short v4i16_t __attribute__((ext_vector_type(4)));
__device__ __forceinline__ void ph_mix2(const Ctx& C, const bf16* __restrict__ Z, const float* __restrict__ VST, const float* __restrict__ lng, const float* __restrict__ lnb,
                                        const bf16* __restrict__ WSb, const float* __restrict__ bs, bf16* __restrict__ G) {
    constexpr int VROW = 528, WROW = 272, V_OFF = 0, W_OFF = 128 * VROW, ST_OFF = W_OFF + 128 * WROW;
    LAS unsigned char* Vl = C.lds + V_OFF; LAS unsigned char* Wl = C.lds + W_OFF; LAS float* ST = (LAS float*)(C.lds + ST_OFF);
    const int tid = C.tid, lane = C.lane, w = C.wave, fr = lane & 15, fq = lane >> 4;
    for (int it = blockIdx.x; it < 2 * (M / CH); it += gridDim.x) {
        const int chunk = it >> 1; const size_t row0 = (size_t)chunk * CH;
        __syncthreads();
        {
            const int r = tid >> 2, q4 = tid & 3; const float* p = VST + ((row0 + r) * 32 + q4 * 8) * 2; float s1 = 0.f, s2 = 0.f;
#pragma unroll
            for (int k = 0; k < 4; ++k) { const f32x4 v = *(const f32x4*)(p + 4 * k); s1 += v[0] + v[2]; s2 += v[1] + v[3]; }
            s1 += __shfl_xor(s1, 1); s1 += __shfl_xor(s1, 2); s2 += __shfl_xor(s2, 1); s2 += __shfl_xor(s2, 2);
            const float mean = s1 * (1.f / GW), var = s2 * (1.f / GW) - mean * mean;
            if (q4 == 0) { ST[2 * r] = mean; ST[2 * r + 1] = 1.f / sqrtf(fmaxf(var, 0.f) + LN_EPS); }
        }
        for (int gi = 0; gi < 4; ++gi) {
            const int g = 4 * (it & 1) + gi;
            __syncthreads();
#pragma unroll
            for (int i = 0; i < 4; ++i) { const int idx = tid + 512 * i, t = idx >> 4, ch = idx & 15;
                *(LAS u32x4*)(Wl + t * WROW + ch * 16) = *(const u32x4*)(WSb + ((size_t)g * CH + t) * CH + ch * 8); }
            {   const int c8 = tid & 31; const float* gp = lng + 256 * g + 8 * c8; const float* bp = lnb + 256 * g + 8 * c8;
                const f32x4 ga = *(const f32x4*)gp, gb = *(const f32x4*)(gp + 4), ba = *(const f32x4*)bp, bb = *(const f32x4*)(bp + 4);
#pragma unroll
                for (int i = 0; i < 8; ++i) { const int sr = (tid >> 5) + 16 * i;
                    const u32x4 raw = *(const u32x4*)(Z + (row0 + sr) * 4096 + GW + 256 * g + 8 * c8);
                    const float mean = ST[2 * sr], rstd = ST[2 * sr + 1]; u32x4 o;
                    o.x = pk2((bf2f(raw.x & 0xffff) - mean) * rstd * ga[0] + ba[0], (bf2f(raw.x >> 16) - mean) * rstd * ga[1] + ba[1]);
                    o.y = pk2((bf2f(raw.y & 0xffff) - mean) * rstd * ga[2] + ba[2], (bf2f(raw.y >> 16) - mean) * rstd * ga[3] + ba[3]);
                    o.z = pk2((bf2f(raw.z & 0xffff) - mean) * rstd * gb[0] + bb[0], (bf2f(raw.z >> 16) - mean) * rstd * gb[1] + bb[1]);
                    o.w = pk2((bf2f(raw.w & 0xffff) - mean) * rstd * gb[2] + bb[2], (bf2f(raw.w >> 16) - mean) * rstd * gb[3] + bb[3]);
                    *(LAS u32x4*)(Vl + sr * VROW + c8 * 16) = o; } }
            __syncthreads();
            bf16x8 vf[2][4];
#pragma unroll
            for (int ct = 0; ct < 2; ++ct)
#pragma unroll
                for (int ks = 0; ks < 4; ++ks) { LAS unsigned char* ap = Vl + (32 * ks + 8 * fq + (fr >> 2)) * VROW + (32 * w + 8 * (fr & 3) + 4 * ct) * 2;
                    const v4i16_t lo = __builtin_amdgcn_ds_read_tr16_b64_v4i16((LAS v4i16_t*)ap), hi = __builtin_amdgcn_ds_read_tr16_b64_v4i16((LAS v4i16_t*)(ap + 4 * VROW));
                    vf[ct][ks] = (bf16x8){lo[0], lo[1], lo[2], lo[3], hi[0], hi[1], hi[2], hi[3]}; }
            f32x4 acc[8][2];
#pragma unroll
            for (int tt = 0; tt < 8; ++tt) { acc[tt][0] = (f32x4){0.f, 0.f, 0.f, 0.f}; acc[tt][1] = (f32x4){0.f, 0.f, 0.f, 0.f}; }
#pragma unroll
            for (int tt = 0; tt < 8; ++tt)
#pragma unroll
                for (int ks = 0; ks < 4; ++ks) if (32 * ks <= 16 * tt + 15) {
                    const bf16x8 wf = *(const LAS bf16x8*)(Wl + (16 * tt + fr) * WROW + (32 * ks + 8 * fq) * 2);
                    acc[tt][0] = __builtin_amdgcn_mfma_f32_16x16x32_bf16(vf[0][ks], wf, acc[tt][0], 0, 0, 0);
                    acc[tt][1] = __builtin_amdgcn_mfma_f32_16x16x32_bf16(vf[1][ks], wf, acc[tt][1], 0, 0, 0); }
#pragma unroll
            for (int tt = 0; tt < 8; ++tt) { const int t = 16 * tt + fr; const float bsv = bs[g * CH + t]; const int cb = 256 * g + 32 * w + 8 * fq;
                const u32x4 uu = *(const u32x4*)(Z + (row0 + t) * 4096 + cb); u32x4 o;
                o.x = pk2(bf2f(uu.x & 0xffff) * (acc[tt][0][0] + bsv), bf2f(uu.x >> 16) * (acc[tt][0][1] + bsv)); o.y = pk2(bf2f(uu.y & 0xffff) * (acc[tt][0][2] + bsv), bf2f(uu.y >> 16) * (acc[tt][0][3] + bsv));
                o.z = pk2(bf2f(uu.z & 0xffff) * (acc[tt][1][0] + bsv), bf2f(uu.z >> 16) * (acc[tt][1][1] + bsv)); o.w = pk2(bf2f(uu.w & 0xffff) * (acc[tt][1][2] + bsv), bf2f(uu.w >> 16) * (acc[tt][1][3] + bsv));
                *(u32x4*)(G + (row0 + t) * GW + cb) = o; }
        }
    }
    __syncthreads();
}

__device__ __forceinline__ void ph_flogit(const Ctx& C, const float* __restrict__ X, const float* __restrict__ MODl, const float* __restrict__ w_in, const float* __restrict__ b_f, float* __restrict__ LF) {
    LAS float* WF = (LAS float*)C.lds;
    for (int i = C.tid; i < D * 4; i += NWAVES * 64) { const int d = i >> 2, q = i & 3; *(LAS f32x4*)(WF + d * 20 + 4 * q) = *(const f32x4*)(w_in + (size_t)d * (3 * D + H) + 3 * D + 4 * q); }
    __syncthreads();
    const int lane = C.lane;
    for (int rb = C.gw; rb < M / 8; rb += C.NGW) {
        const int row0 = rb * 8, b = row0 / S;
        const float* sh = MODl + (size_t)b * 6 * D; const float* sc = sh + D;
        float acc[8][16];
#pragma unroll
        for (int r = 0; r < 8; ++r)
#pragma unroll
            for (int j = 0; j < 16; ++j) acc[r][j] = 0.f;
#pragma unroll 2
        for (int i = 0; i < 16; ++i) {
            const int d = lane + 64 * i; const float s1 = 1.f + sc[d], s0 = sh[d];
            float hv[8];
#pragma unroll
            for (int r = 0; r < 8; ++r) hv[r] = X[(size_t)(row0 + r) * D + d] * s1 + s0;
            const f32x4 w0 = *(const LAS f32x4*)(WF + d * 20), w1 = *(const LAS f32x4*)(WF + d * 20 + 4), w2 = *(const LAS f32x4*)(WF + d * 20 + 8), w3 = *(const LAS f32x4*)(WF + d * 20 + 12);
#pragma unroll
            for (int r = 0; r < 8; ++r) {
#pragma unroll
                for (int j = 0; j < 4; ++j) { acc[r][j] += hv[r] * w0[j]; acc[r][4 + j] += hv[r] * w1[j]; acc[r][8 + j] += hv[r] * w2[j]; acc[r][12 + j] += hv[r] * w3[j]; } }
        }
        float mine = 0.f;
        float mine2 = 0.f;
#pragma unroll
        for (int r = 0; r < 8; ++r)
#pragma unroll
            for (int j = 0; j < 16; ++j) { const float t = wave_sum(acc[r][j]); if (r < 4) { if (lane == r * 16 + j) mine = t; } else { if (lane == (r - 4) * 16 + j) mine2 = t; } }
        const float bf_ = b_f[lane & 15];
        { const float zz = mine + bf_; const float ls = (zz >= 0.f) ? -log1pf(__expf(-zz)) : zz - log1pf(__expf(zz)); LF[(size_t)(row0 + (lane >> 4)) * 16 + (lane & 15)] = ls; }
        { const float zz = mine2 + bf_; const float ls = (zz >= 0.f) ? -log1pf(__expf(-zz)) : zz - log1pf(__expf(zz)); LF[(size_t)(row0 + 4 + (lane >> 4)) * 16 + (lane & 15)] = ls; }
    }
    __syncthreads();
}
__device__ __forceinline__ void ph_fscan(const Ctx& C, const float* __restrict__ LF, float* __restrict__ CUM) {
    LAS float* WT_ = (LAS float*)C.lds;
    for (int bh = blockIdx.x; bh < NB * H; bh += gridDim.x) {
        const int b = bh / H, h = bh % H, s0 = C.tid * 16;
        float v[16]; float run = 0.f;
#pragma unroll
        for (int i = 0; i < 16; ++i) { run += LF[((size_t)b * S + s0 + i) * 16 + h]; v[i] = run; }
        float incl = run;
#pragma unroll
        for (int o = 1; o < 64; o <<= 1) { const float t = __shfl_up(incl, o); if (C.lane >= o) incl += t; }
        __syncthreads();
        if (C.lane == 63) WT_[C.wave] = incl;
        __syncthreads();
        float off = incl - run;
#pragma unroll
        for (int w8 = 0; w8 < 8; ++w8) if (w8 < C.wave) off += WT_[w8];
#pragma unroll
        for (int q = 0; q < 4; ++q) { f32x4 o; o[0] = -(off + v[4 * q]) * LOG2E; o[1] = -(off + v[4 * q + 1]) * LOG2E; o[2] = -(off + v[4 * q + 2]) * LOG2E; o[3] = -(off + v[4 * q + 3]) * LOG2E;
            *(f32x4*)(CUM + (size_t)bh * S + s0 + 4 * q) = o; }
    }
}
__device__ __forceinline__ void ph_attn(const Ctx& C, const bf16* __restrict__ Q, const bf16* __restrict__ Kb, const bf16* __restrict__ Vb, const float* __restrict__ CUM, bf16* __restrict__ AO) {
    for (int gq = C.gw; gq < NB * H * S; gq += C.NGW) {
        const int lane = C.lane;
        const int t = gq % S, bh = gq / S, b = bh / H, h = bh % H;
        const size_t rowb = (size_t)b * S;
        float q[64];
        {
            const bf16* qp = Q + (rowb + t) * D + h * HD;
#pragma unroll
            for (int i = 0; i < 8; ++i) { const u32x4 w = *(const u32x4*)(qp + 8 * i);
#pragma unroll
                for (int j = 0; j < 4; ++j) { q[8 * i + 2 * j] = bf2f(w[j] & 0xffff); q[8 * i + 2 * j + 1] = bf2f(w[j] >> 16); } }
        }
        const float* cum = CUM + (size_t)bh * S;
        const float cq = -cum[t];
        float m = -INFINITY, l = 0.f, o = 0.f;
        for (int kb = 0; kb <= t; kb += 64) {
            const int key = kb + lane; const bool valid = key <= t;
            float s = -INFINITY;
            if (valid) {
                const bf16* kp = Kb + (rowb + key) * D + h * HD; float dot = 0.f;
#pragma unroll
                for (int i = 0; i < 8; ++i) { const u32x4 w = *(const u32x4*)(kp + 8 * i);
#pragma unroll
                    for (int j = 0; j < 4; ++j) { dot += q[8 * i + 2 * j] * bf2f(w[j] & 0xffff); dot += q[8 * i + 2 * j + 1] * bf2f(w[j] >> 16); } }
                s = dot + cq + cum[key];
            }
            const float mnew = fmaxf(m, wave_max(s));
            const float p = valid ? exp2f(s - mnew) : 0.f;
            const float corr = exp2f(m - mnew);
            l = l * corr + wave_sum(p); o *= corr;
            const int nk = (t - kb + 1 < 64) ? (t - kb + 1) : 64;
            for (int j = 0; j < nk; ++j) { const float pj = __shfl(p, j); o += pj * bf2f(Vb[(rowb + kb + j) * D + h * HD + lane]); }
            m = mnew;
        }
        AO[(rowb + t) * D + h * HD + lane] = (bf16)f2bf(o / l);
    }
}

__device__ __forceinline__ void ph_pool(const Ctx& C, const bf16* __restrict__ PZ, bf16* __restrict__ PP) {
    const int c8 = C.tid & 127, rbk = C.tid >> 7, col = 8 * c8, win = 2 << (col >> 8);
    for (int vb = blockIdx.x; vb < M / 64; vb += gridDim.x) {
        const int r0 = (vb * 4 + rbk) * 16, pos0 = r0 % S;
        float sum[8];
#pragma unroll
        for (int k = 0; k < 8; ++k) sum[k] = 0.f;
        for (int j = 1; j < win; ++j) if (pos0 - j >= 0) { const u32x4 w = *(const u32x4*)(PZ + (size_t)(r0 - j) * D + col);
#pragma unroll
            for (int k = 0; k < 4; ++k) { sum[2 * k] += bf2f(w[k] & 0xffff); sum[2 * k + 1] += bf2f(w[k] >> 16); } }
#pragma unroll 4
        for (int r = 0; r < 16; ++r) {
            const int pos = pos0 + r; const u32x4 w = *(const u32x4*)(PZ + (size_t)(r0 + r) * D + col);
            float z[8];
#pragma unroll
            for (int k = 0; k < 4; ++k) { z[2 * k] = bf2f(w[k] & 0xffff); z[2 * k + 1] = bf2f(w[k] >> 16); }
            const float inv = 1.f / (float)((pos + 1 < win) ? pos + 1 : win);
            u32x4 o;
#pragma unroll
            for (int k = 0; k < 4; ++k) { sum[2 * k] += z[2 * k]; sum[2 * k + 1] += z[2 * k + 1]; o[k] = pk2(sum[2 * k] * inv - z[2 * k], sum[2 * k + 1] * inv - z[2 * k + 1]); }
            *(u32x4*)(PP + (size_t)(r0 + r) * D + col) = o;
            if (pos - win + 1 >= 0) { const u32x4 wo = *(const u32x4*)(PZ + (size_t)(r0 + r - win + 1) * D + col);
#pragma unroll
                for (int k = 0; k < 4; ++k) { sum[2 * k] -= bf2f(wo[k] & 0xffff); sum[2 * k + 1] -= bf2f(wo[k] >> 16); } }
        }
    }
}

__device__ __forceinline__ void ph_route(const Ctx& C, const float* __restrict__ X, const float* __restrict__ MODl, const float* __restrict__ wr, const float* __restrict__ br,
                                         int* __restrict__ cnt, int* __restrict__ tok_e, float* __restrict__ tok_g, int* __restrict__ tok_pos, bf16* __restrict__ XS) {
    f32x4 wq[16][2];
#pragma unroll
    for (int i = 0; i < 4; ++i)
#pragma unroll
        for (int j = 0; j < 4; ++j) { const int d = C.lane * 4 + 256 * i + j; wq[4 * i + j][0] = *(const f32x4*)(wr + (size_t)d * 8); wq[4 * i + j][1] = *(const f32x4*)(wr + (size_t)d * 8 + 4); }
    for (int row = C.gw; row < M; row += C.NGW) {
        const int lane = C.lane, b = row / S;
        const float* sh = MODl + (size_t)b * 6 * D + 3 * D; const float* sc = sh + D;
        float acc[8];
#pragma unroll
        for (int j = 0; j < 8; ++j) acc[j] = 0.f;
        u32x2 hw[4];
#pragma unroll
        for (int i = 0; i < 4; ++i) {
            const int col = lane * 4 + 256 * i;
            const f32x4 xv = *(const f32x4*)(X + (size_t)row * D + col);
            const f32x4 h = xv * (1.f + *(const f32x4*)(sc + col)) + *(const f32x4*)(sh + col);
            hw[i].x = pk2(h[0], h[1]); hw[i].y = pk2(h[2], h[3]);
#pragma unroll
            for (int j = 0; j < 4; ++j) {
                const f32x4 w0 = wq[4 * i + j][0], w1 = wq[4 * i + j][1];
                acc[0] += h[j] * w0[0]; acc[1] += h[j] * w0[1]; acc[2] += h[j] * w0[2]; acc[3] += h[j] * w0[3];
                acc[4] += h[j] * w1[0]; acc[5] += h[j] * w1[1]; acc[6] += h[j] * w1[2]; acc[7] += h[j] * w1[3];
            }
        }
#pragma unroll
        for (int j = 0; j < 8; ++j) acc[j] = wave_sum(acc[j]) + br[j];
        int e0 = 0; float v0 = acc[0];
#pragma unroll
        for (int j = 1; j < 8; ++j) if (acc[j] > v0) { v0 = acc[j]; e0 = j; }
        int e1 = -1; float v1 = -INFINITY;
#pragma unroll
        for (int j = 0; j < 8; ++j) if (j != e0 && acc[j] > v1) { v1 = acc[j]; e1 = j; }
        int p0 = 0, p1 = 0;
        if (lane == 0) {
            const float ex = __expf(v1 - v0), g0 = 1.f / (1.f + ex), g1 = ex / (1.f + ex);
            p0 = atomicAdd(&cnt[e0], 1); p1 = atomicAdd(&cnt[e1], 1);
            tok_e[row * 2] = e0; tok_e[row * 2 + 1] = e1; tok_g[row * 2] = g0; tok_g[row * 2 + 1] = g1; tok_pos[row * 2] = p0; tok_pos[row * 2 + 1] = p1;
        }
        p0 = __builtin_amdgcn_readfirstlane(p0); p1 = __builtin_amdgcn_readfirstlane(p1);
        e0 = __builtin_amdgcn_readfirstlane(e0); e1 = __builtin_amdgcn_readfirstlane(e1);
        bf16* d0 = XS + ((size_t)e0 * M + p0) * D; bf16* d1 = XS + ((size_t)e1 * M + p1) * D;
#pragma unroll
        for (int i = 0; i < 4; ++i) { const int col = lane * 4 + 256 * i; *(u32x2*)(d0 + col) = hw[i]; *(u32x2*)(d1 + col) = hw[i]; }
    }
}

__device__ __forceinline__ GF mkgf(const bf16* A, int lda, int K, const float* B, int ldb, int mode, void* out, int ldo) {
    GF f; f.A = A; f.gather = nullptr; f.cnt = nullptr; f.B = B; f.bz = 0; f.out = out; f.colscale = nullptr; f.lda = lda; f.K = K; f.Mrows = M; f.a_compact = 0; f.ldb = ldb; f.mode = mode; f.ldo = ldo; f.grouped = 0; return f;
}
__global__ void __launch_bounds__(NWAVES * 64, 2) mega_fwd(Args args) {
    extern __shared__ __attribute__((aligned(16))) unsigned char lds_raw[];
    LAS unsigned char* const ldsb = (LAS unsigned char*)lds_raw;
    volatile LAS unsigned* MISC = (volatile LAS unsigned*)(ldsb + MISC_OFF);
    if (threadIdx.x < 32) MISC[threadIdx.x] = 0u;
    __syncthreads();
    unsigned char* ws = args.ws;
    XcdBarrier bar = xcd_barrier_post((unsigned*)(ws + WS_CTL) + CW_BAR, MISC + 8);
#define GRID_BAR() xcd_barrier(bar)

    const float* x = args.in[0]; const float* c = args.in[1]; const float* mod_w = args.in[2]; const float* mod_b = args.in[3];
    const float* ln_g = args.in[4]; const float* ln_b = args.in[5];
    const float* gm_w_in = args.in[6]; const float* gm_ln_g = args.in[7]; const float* gm_ln_b = args.in[8];
    const float* gm_w_s = args.in[9]; const float* gm_b_s = args.in[10]; const float* gm_w_out = args.in[11];
    const float* fox_w_in = args.in[12]; const float* fox_b_f = args.in[13]; const float* fox_w_out = args.in[14];
    const float* pool_w_in = args.in[15]; const float* pool_w_grp = args.in[16]; const float* pool_scale = args.in[17]; const float* pool_w_out = args.in[18];
    const float* ffn_w13 = args.in[19]; const float* ffn_w2 = args.in[20];
    const float* moe_wr = args.in[21]; const float* moe_br = args.in[22]; const float* moe_w13 = args.in[23]; const float* moe_w2 = args.in[24];
    int* ctl = (int*)(ws + WS_CTL); float* MOD = (float*)(ws + WS_MOD); float* X = (float*)(ws + WS_X); float* Y = (float*)(ws + WS_Y);
    bf16* Hb = (bf16*)(ws + WS_H); bf16* Z = (bf16*)(ws + WS_Z); bf16* VLN = (bf16*)(ws + WS_VLN); bf16* G = (bf16*)(ws + WS_G); bf16* ACT = (bf16*)(ws + WS_ACT);
    bf16* Qb = (bf16*)(ws + WS_Q); bf16* Kb = Qb + (size_t)M * D; bf16* Vb = Kb + (size_t)M * D; bf16* AO = (bf16*)(ws + WS_AO);
    float* LF = (float*)(ws + WS_LF); float* CUM = (float*)(ws + WS_CUM);
    bf16* PZ = (bf16*)(ws + WS_PZ); bf16* PP = (bf16*)(ws + WS_PP); bf16* PG = (bf16*)(ws + WS_PG); bf16* YS = (bf16*)(ws + WS_YS);
    int* tok_e = (int*)(ws + WS_RT); float* tok_g = (float*)(ws + WS_RT + 128 * 1024); int* tok_pos = (int*)(ws + WS_RT + 256 * 1024); int* list = (int*)(ws + WS_RT + 512 * 1024);

    float* VST = (float*)(ws + WS_VST); bf16* XS = (bf16*)(ws + WS_XS);
    const int G_ = (int)gridDim.x;
#ifndef FAST_GEMM
#define FAST_GEMM 1
#endif
#ifndef FAST_MIX
#define FAST_MIX 1
#endif
#define FASTG(EPI, SCHED, ALIGN, Aptr, WTptr, lda_, K_, Nn_, Einit, Sextra) do { pg8::Gemm g{(const pg8::bf16_t*)(Aptr), (const pg8::bf16_t*)(WTptr), (lda_), (K_)}; \
        SCHED S_; S_.init(M, (Nn_), G_, (int)blockIdx.x); Sextra; EPI E_ Einit; pg8::gemm_phase<EPI, SCHED, ALIGN, true>(ldsb, g, S_, E_); } while (0)
    ph_mod(mkctx(ldsb), c, mod_w, mod_b, MOD);
#if FAST_GEMM
    { CvtPtrs P; P.gm_ws = gm_w_s; P.gm_in = gm_w_in; P.gm_out = gm_w_out; P.fox_in = fox_w_in; P.fox_out = fox_w_out; P.pool_in = pool_w_in; P.pool_out = pool_w_out; P.pool_grp = pool_w_grp;
      P.ffn13 = ffn_w13; P.ffn2 = ffn_w2; P.moe13 = moe_w13; P.moe2 = moe_w2; P.ws = ws; ph_convert(mkctx(ldsb), P); }
#endif
    GRID_BAR();
    ph_modulate(mkctx(ldsb), x, MOD, Hb); GRID_BAR();

#define LN_PHASE(i_, sub_, xin_, last_) do { LnArgs a; a.xin = (xin_); a.y = Y; a.xout = (last_) ? args.out : X; a.hout = (last_) ? nullptr : Hb; \
        a.gate = MOD + (size_t)(i_) * 2 * 6 * D + ((sub_) ? 5 : 2) * D; a.gamma = ln_g + (size_t)((i_) * 2 + (sub_)) * D; a.beta = ln_b + (size_t)((i_) * 2 + (sub_)) * D; \
        a.nsh = (sub_) ? MOD + (size_t)((i_) + 1) * 2 * 6 * D : MOD + (size_t)(i_) * 2 * 6 * D + 3 * D; \
        a.ys = nullptr; a.tok_e = nullptr; a.tok_pos = nullptr; a.tok_g = nullptr; a.cnt = nullptr; ph_ln(mkctx(ldsb), a); GRID_BAR(); } while (0)
#define GMLP(i_, j_, xin_) do { \
        if (FAST_GEMM) FASTG(pg8::EpiBf16<1>, pg8::SchedPlain, true, Hb, ws + WT_GM_IN + (size_t)(j_) * 4096 * D * 2, D, D, 4096, ({Z, 4096, 0, (size_t)0, 1.f, nullptr, VST, 8}), S_.btoff = 0); \
        else { GF f = mkgf(Hb, D, D, gm_w_in + (size_t)(j_) * D * 4096, 4096, EP_GELU, Z, 4096); ph_gemm(mkctx(ldsb), f, 4096 / 64, 1); } GRID_BAR(); \
        if (FAST_MIX) { ph_mix2(mkctx(ldsb), Z, VST, gm_ln_g + (size_t)(j_) * GW, gm_ln_b + (size_t)(j_) * GW, (const bf16*)(ws + WT_GMS) + (size_t)(j_) * GMG * CH * CH, gm_b_s + (size_t)(j_) * GMG * CH, G); GRID_BAR(); } \
        else { ph_vln(mkctx(ldsb), Z, gm_ln_g + (size_t)(j_) * GW, gm_ln_b + (size_t)(j_) * GW, VLN); GRID_BAR(); \
        ph_mix(mkctx(ldsb), Z, VLN, gm_w_s + (size_t)(j_) * GMG * CH * CH, gm_b_s + (size_t)(j_) * GMG * CH, G); GRID_BAR(); } \
        if (FAST_GEMM) FASTG(pg8::EpiF32, pg8::SchedPlain, true, G, ws + WT_GM_OUT + (size_t)(j_) * D * GW * 2, GW, GW, D, ({Y, D}), S_.btoff = 0); \
        else { GF f = mkgf(G, GW, GW, gm_w_out + (size_t)(j_) * GW * D, D, EP_F32, Y, D); ph_gemm(mkctx(ldsb), f, D / 64, 1); } GRID_BAR(); \
        LN_PHASE(i_, 0, xin_, false); } while (0)
#define FFN(i_, fi_, last_) do { \
        if (FAST_GEMM) FASTG(pg8::EpiSwiglu, pg8::SchedPlain, true, Hb, ws + WT_FFN13 + (size_t)(fi_) * 2 * F * D * 2, D, D, 2 * F, ({ACT, F}), S_.btoff = 0); \
        else { GF f = mkgf(Hb, D, D, ffn_w13 + (size_t)(fi_) * D * 2 * F, 2 * F, EP_SWIGLU, ACT, F); ph_gemm(mkctx(ldsb), f, F / 32, 1); } GRID_BAR(); \
        if (FAST_GEMM) FASTG(pg8::EpiF32, pg8::SchedPlain, true, ACT, ws + WT_FFN2 + (size_t)(fi_) * D * F * 2, F, F, D, ({Y, D}), S_.btoff = 0); \
        else { GF f = mkgf(ACT, F, F, ffn_w2 + (size_t)(fi_) * F * D, D, EP_F32, Y, D); ph_gemm(mkctx(ldsb), f, D / 64, 1); } GRID_BAR(); \
        LN_PHASE(i_, 1, X, last_); } while (0)
#define MOE(i_, mi_, last_) do { int* cnt = ctl + CW_CNT + 16 * (mi_); \
        ph_route(mkctx(ldsb), X, MOD + (size_t)(i_) * 2 * 6 * D, moe_wr + (size_t)(mi_) * D * NE, moe_br + (size_t)(mi_) * NE, cnt, tok_e, tok_g, tok_pos, XS); GRID_BAR(); \
        if (FAST_GEMM) { pg8::Gemm g{(const pg8::bf16_t*)XS, (const pg8::bf16_t*)(ws + WT_MOE13 + (size_t)(mi_) * NE * 2 * F * D * 2), D, D}; pg8::SchedMoE<true> S_; S_.setup(cnt, 2 * F, G_, (int)blockIdx.x); \
            pg8::EpiSwiglu E_{ACT, F}; pg8::gemm_phase<pg8::EpiSwiglu, pg8::SchedMoE<true>, true, true>(ldsb, g, S_, E_); } \
        else { GF f = mkgf(XS, D, D, moe_w13 + (size_t)(mi_) * NE * D * 2 * F, 2 * F, EP_SWIGLU, ACT, F); f.gather = tok_e; f.cnt = cnt; f.bz = (size_t)D * 2 * F; ph_gemm(mkctx(ldsb), f, F / 32, NE); } GRID_BAR(); \
        if (FAST_GEMM) { pg8::Gemm g{(const pg8::bf16_t*)ACT, (const pg8::bf16_t*)(ws + WT_MOE2 + (size_t)(mi_) * NE * D * F * 2), F, F}; pg8::SchedMoE<false> S_; S_.setup(cnt, D, G_, (int)blockIdx.x); \
            pg8::EpiBf16<0> E_{YS, D, 0, (size_t)0, 1.f, nullptr, nullptr, 0}; pg8::gemm_phase<pg8::EpiBf16<0>, pg8::SchedMoE<false>, true, true>(ldsb, g, S_, E_); } \
        else { GF f = mkgf(ACT, F, F, moe_w2 + (size_t)(mi_) * NE * F * D, D, EP_BF16, YS, D); f.cnt = cnt; f.a_compact = 1; f.bz = (size_t)F * D; ph_gemm(mkctx(ldsb), f, D / 64, NE); } GRID_BAR(); \
        { LnArgs a; a.xin = X; a.y = nullptr; a.xout = (last_) ? args.out : X; a.hout = (last_) ? nullptr : Hb; \
          a.gate = MOD + (size_t)(i_) * 2 * 6 * D + 5 * D; a.gamma = ln_g + (size_t)((i_) * 2 + 1) * D; a.beta = ln_b + (size_t)((i_) * 2 + 1) * D; a.nsh = MOD + (size_t)((i_) + 1) * 2 * 6 * D; \
          a.ys = YS; a.tok_e = tok_e; a.tok_pos = tok_pos; a.tok_g = tok_g; a.cnt = cnt; ph_ln(mkctx(ldsb), a); } if (!(last_)) GRID_BAR(); } while (0)

    GMLP(0, 0, x);
    FFN(0, 0, false);
    if (FAST_GEMM) FASTG(pg8::EpiBf16<0>, pg8::SchedPlain, true, Hb, ws + WT_FOX_IN, D, D, 3 * D, ({Qb, D, D, (size_t)M * D, QSCALE, nullptr, nullptr, 0}), S_.btoff = 0);
    else { GF f = mkgf(Hb, D, D, fox_w_in, 3 * D + H, EP_QKV, Qb, D); ph_gemm(mkctx(ldsb), f, 3 * D / 64, 1); }
    ph_flogit(mkctx(ldsb), X, MOD + (size_t)1 * 2 * 6 * D, fox_w_in, fox_b_f, LF); GRID_BAR();
    ph_fscan(mkctx(ldsb), LF, CUM); GRID_BAR();
#ifndef FAST_ATTN
#define FAST_ATTN 1
#endif
    if (FAST_ATTN) { static_assert(attn_body::ATTN_LDS_BYTES <= 131072, "attention LDS");
        const attn_body::AttnTensors AT{(const attn_body::bf16*)Qb, (const attn_body::bf16*)Kb, (const attn_body::bf16*)Vb, (attn_body::bf16*)AO, CUM};
        const attn_body::StaticOrder SA(G_, (int)blockIdx.x); attn_body::attn_phase<attn_body::StaticOrder>((char*)lds_raw, AT, SA); }
    else ph_attn(mkctx(ldsb), Qb, Kb, Vb, CUM, AO);
    GRID_BAR();
    if (FAST_GEMM) FASTG(pg8::EpiF32, pg8::SchedPlain, true, AO, ws + WT_FOX_OUT, D, D, D, ({Y, D}), S_.btoff = 0);
    else { GF f = mkgf(AO, D, D, fox_w_out, D, EP_F32, Y, D); ph_gemm(mkctx(ldsb), f, D / 64, 1); } GRID_BAR();
    LN_PHASE(1, 0, X, false);
    MOE(1, 0, false);
    if (FAST_GEMM) FASTG(pg8::EpiBf16<0>, pg8::SchedPlain, true, Hb, ws + WT_POOL_IN, D, D, D, ({PZ, D, 0, (size_t)0, 1.f, nullptr, nullptr, 0}), S_.btoff = 0);
    else { GF f = mkgf(Hb, D, D, pool_w_in, D, EP_BF16, PZ, D); ph_gemm(mkctx(ldsb), f, D / 64, 1); } GRID_BAR();
    ph_pool(mkctx(ldsb), PZ, PP); GRID_BAR();
    if (FAST_GEMM) FASTG(pg8::EpiBf16<0>, pg8::SchedPoolGrp, true, PP, ws + WT_POOL_GRP, D, 256, D, ({PG, D, 0, (size_t)0, 1.f, pool_scale, nullptr, 0}), (void)0);
    else { GF f = mkgf(PP, D, 256, pool_w_grp, 256, EP_BF16, PG, D); f.colscale = pool_scale; f.grouped = 1; ph_gemm(mkctx(ldsb), f, D / 64, 1); } GRID_BAR();
    if (FAST_GEMM) FASTG(pg8::EpiF32, pg8::SchedPlain, true, PG, ws + WT_POOL_OUT, D, D, D, ({Y, D}), S_.btoff = 0);
    else { GF f = mkgf(PG, D, D, pool_w_out, D, EP_F32, Y, D); ph_gemm(mkctx(ldsb), f, D / 64, 1); } GRID_BAR();
    LN_PHASE(2, 0, X, false);
    FFN(2, 1, false);
    GMLP(3, 1, X);
    MOE(3, 1, true);
}

extern "C" void kernel_launch(void* const* d_in, const int* in_sizes, int n_in, void* d_out, int out_size, void* d_ws, size_t ws_size, hipStream_t stream) {
    static int grid = 0;
    if (grid == 0) {
        if (n_in != 25 || ws_size < WS_END || out_size != M * D) { fprintf(stderr, "kernel_launch: unexpected shapes (n_in %d, ws %zu, out %d)\n", n_in, ws_size, out_size); grid = -1; return; }
        int dev = 0, cus = 0, per_cu = 0;
        if (hipGetDevice(&dev) != hipSuccess || hipDeviceGetAttribute(&cus, hipDeviceAttributeMultiprocessorCount, dev) != hipSuccess) { grid = -1; return; }
        if (hipFuncSetAttribute((const void*)mega_fwd, hipFuncAttributeMaxDynamicSharedMemorySize, LDS_BYTES) != hipSuccess) { fprintf(stderr, "kernel_launch: hipFuncSetAttribute failed\n"); grid = -1; return; }
        if (hipOccupancyMaxActiveBlocksPerMultiprocessor(&per_cu, (const void*)mega_fwd, NWAVES * 64, LDS_BYTES) != hipSuccess || per_cu < 1) { fprintf(stderr, "kernel_launch: occupancy query says %d\n", per_cu); }
        (void)hipGetLastError();
        grid = cus;
    }
    if (grid < 0) return;
    if (hipMemsetAsync((char*)d_ws + WS_CTL, 0, CTL_ZERO_BYTES, stream) != hipSuccess) return;
    Args a; memset(&a, 0, sizeof a);
    for (int i = 0; i < 25; ++i) a.in[i] = (const float*)d_in[i];
    a.out = (float*)d_out; a.ws = (unsigned char*)d_ws;
    hipLaunchKernelGGL(mega_fwd, dim3(grid), dim3(NWAVES * 64), LDS_BYTES, stream, a);
}
```
